# Optimizing an MI355X kernel written in HIP

```python
import jax
import jax.numpy as jnp
from jax import lax
import numpy as np

D_MODEL = 1024
BATCH = 2
SEQ = 8192
DEPTH = 4

GRID_W = 64
CTX_LEN = 256
HEAD_DIM = 64
ATT_HEADS = 8
KV_HEADS = 2
Q_PER_KV = ATT_HEADS // KV_HEADS
ATT_W = ATT_HEADS * HEAD_DIM
KV_W = KV_HEADS * HEAD_DIM
WINDOW = 128
ROPE_THETA = 10000.0
CHUNK = 128
SGU_GROUPS = 4
SGU_GW = 128
SGU_W = SGU_GROUPS * SGU_GW
LRU_W = D_MODEL
LRU_BLOCKS = 8
LRU_BW = LRU_W // LRU_BLOCKS
CONV_W = 4
LRU_C = 8.0
N_BRANCHES = 3
N_GROUPS = 4
EXPERTS_PER_GROUP = 8
N_EXPERTS = N_GROUPS * EXPERTS_PER_GROUP
TOP_K = 2
D_EXPERT = 512
MOE_BLOCK = 128
N_MOD = 6
COL_WIDTHS = (ATT_W, SGU_W, SGU_W, N_BRANCHES * D_MODEL, LRU_W, KV_W, KV_W, LRU_W)
IN_W = ATT_W + 2 * SGU_W + N_BRANCHES * D_MODEL + LRU_W + 2 * KV_W + LRU_W
CTX_COL_OFF = IN_W - (2 * KV_W + LRU_W)
ALPHA = (2.0 * DEPTH) ** 0.25
BETA = (8.0 * DEPTH) ** -0.25
LN_EPS = 1e-6
NEG_INF = -1e30

kernel_name = 'hybrid_gated_branch_dit_trunk'


def layer_norm(x, g, b):
    xf = x.astype(jnp.float32)
    mu = jnp.mean(xf, -1, keepdims=True)
    var = jnp.mean(jnp.square(xf - mu), -1, keepdims=True)
    y = (xf - mu) * lax.rsqrt(var + LN_EPS)
    return (y * g.astype(jnp.float32) + b.astype(jnp.float32)).astype(x.dtype)


def split_cols(t, widths):
    return jnp.split(t, np.cumsum(widths)[:-1].tolist(), axis=-1)


def axial_rope_tables(n_tok):
    rows = n_tok // GRID_W
    row = jnp.repeat(jnp.arange(rows, dtype=jnp.float32), GRID_W)
    col = jnp.tile(jnp.arange(GRID_W, dtype=jnp.float32), rows)
    axis_dim = HEAD_DIM // 2
    inv_freq = ROPE_THETA ** (-jnp.arange(0, axis_dim, 2, dtype=jnp.float32) / axis_dim)
    ang_r = row[:, None] * inv_freq
    ang_c = col[:, None] * inv_freq
    return (jnp.cos(ang_r), jnp.sin(ang_r), jnp.cos(ang_c), jnp.sin(ang_c))


def _rotate(x, cos, sin):
    f = cos.shape[-1]
    x1, x2 = x[..., :f], x[..., f:]
    cos = cos[:, None, :]
    sin = sin[:, None, :]
    return jnp.concatenate([x1 * cos - x2 * sin, x2 * cos + x1 * sin], -1)


def apply_axial_rope(x, tables):
    cr, sr, cc, sc = tables
    xf = x.astype(jnp.float32)
    half = HEAD_DIM // 2
    out = jnp.concatenate([_rotate(xf[..., :half], cr, sr), _rotate(xf[..., half:], cc, sc)], -1)
    return out.astype(x.dtype)


def spatial_gating(u, v, ln_g, ln_b, w_spatial, b_spatial):
    bsz, n = u.shape[:2]
    n_chunks = n // CHUNK
    vn = layer_norm(v, ln_g, ln_b).reshape(bsz, n_chunks, CHUNK, SGU_GROUPS, SGU_GW)
    mixed = jnp.einsum('gpq,bnqgc->bnpgc', w_spatial, vn) + b_spatial.T[:, :, None]
    return u * mixed.reshape(bsz, n, SGU_W)


def window_attention(q, k, v, k_ctx, v_ctx, sink):
    bsz, n = q.shape[:2]
    nb = n // WINDOW
    scale = HEAD_DIM ** -0.5
    qb = q.reshape(bsz, nb, WINDOW, KV_HEADS, Q_PER_KV, HEAD_DIM)

    def neighbours(t):
        tp = jnp.pad(t, ((0, 0), (WINDOW, WINDOW), (0, 0), (0, 0)))
        tp = tp.reshape(bsz, nb + 2, WINDOW, KV_HEADS, HEAD_DIM)
        return jnp.concatenate([tp[:, :-2], tp[:, 1:-1], tp[:, 2:]], axis=2)

    kb, vb = neighbours(k), neighbours(v)
    s_loc = jnp.einsum('bnqkgd,bnjkd->bnkgqj', qb, kb, preferred_element_type=jnp.float32) * scale
    s_ctx = jnp.einsum('bnqkgd,bckd->bnkgqc', qb, k_ctx, preferred_element_type=jnp.float32) * scale
    q_idx = jnp.arange(nb)[:, None, None] * WINDOW + jnp.arange(WINDOW)[None, :, None]
    k_idx = (jnp.arange(nb)[:, None, None] - 1) * WINDOW + jnp.arange(3 * WINDOW)[None, None, :]
    valid = (jnp.abs(k_idx - q_idx) <= WINDOW) & (k_idx >= 0) & (k_idx < n)
    s_loc = jnp.where(valid[None, :, None, None], s_loc, NEG_INF)
    sink_l = jnp.broadcast_to(sink.astype(jnp.float32).reshape(KV_HEADS, Q_PER_KV)[:, :, None, None],
                              s_loc.shape[:-1] + (1,))
    n_ctx = k_ctx.shape[1]
    p = jax.nn.softmax(jnp.concatenate([sink_l, s_ctx, s_loc], -1), axis=-1)
    p_ctx = p[..., 1:1 + n_ctx].astype(v.dtype)
    p_loc = p[..., 1 + n_ctx:].astype(v.dtype)
    o = (jnp.einsum('bnkgqc,bckd->bnqkgd', p_ctx, v_ctx)
         + jnp.einsum('bnkgqj,bnjkd->bnqkgd', p_loc, vb))
    return o.reshape(bsz, n, ATT_W)


def context_attention(q, k, v, sink):
    bsz, n = q.shape[:2]
    qg = q.reshape(bsz, n, KV_HEADS, Q_PER_KV, HEAD_DIM)
    s = jnp.einsum('bqkgd,bckd->bkgqc', qg, k, preferred_element_type=jnp.float32) * HEAD_DIM ** -0.5
    sink_l = jnp.broadcast_to(sink.astype(jnp.float32).reshape(KV_HEADS, Q_PER_KV)[:, :, None, None],
                              s.shape[:-1] + (1,))
    p = jax.nn.softmax(jnp.concatenate([sink_l, s], -1), axis=-1)[..., 1:].astype(v.dtype)
    o = jnp.einsum('bkgqc,bckd->bqkgd', p, v)
    return o.reshape(bsz, n, ATT_W)


def short_conv(t, w, b, reverse):
    n = t.shape[1]
    pad = (0, CONV_W - 1) if reverse else (CONV_W - 1, 0)
    tp = jnp.pad(t, ((0, 0), pad, (0, 0)))
    out = b
    for j in range(CONV_W):
        out = out + w[j] * tp[:, j:j + n]
    return out


def block_diag(t, w, b):
    tb = t.reshape(t.shape[:-1] + (LRU_BLOCKS, LRU_BW))
    return jnp.einsum('blnc,ncd->blnd', tb, w).reshape(t.shape) + b


def lru_gates(t, w_r, b_r, w_i, b_i, lam):
    r = jax.nn.sigmoid(block_diag(t, w_r, b_r).astype(jnp.float32))
    i = jax.nn.sigmoid(block_diag(t, w_i, b_i).astype(jnp.float32))
    log_a = -LRU_C * r * jax.nn.softplus(-lam.astype(jnp.float32))
    a = jnp.exp(log_a)
    mult = jnp.sqrt(-jnp.expm1(2.0 * log_a))
    return a, mult * i * t.astype(jnp.float32)


def linear_scan(a, u, h0):
    def combine(left, right):
        return (left[0] * right[0], right[0] * left[1] + right[1])
    a_cum, h = lax.associative_scan(combine, (a, u), axis=1)
    return h + a_cum * h0[:, None, :]


def rglru_direction(x_ctx, x_lat, conv_w, conv_b, w_r, b_r, w_i, b_i, lam, reverse):
    def scan_inputs(t):
        a, u = lru_gates(short_conv(t, conv_w, conv_b, reverse), w_r, b_r, w_i, b_i, lam)
        if reverse:
            return jnp.flip(a, 1), jnp.flip(u, 1)
        return a, u

    a_c, u_c = scan_inputs(x_ctx)
    a_l, u_l = scan_inputs(x_lat)
    h_c = linear_scan(a_c, u_c, jnp.zeros((x_ctx.shape[0], LRU_W), jnp.float32))
    h_l = linear_scan(a_l, u_l, h_c[:, -1])
    if reverse:
        return jnp.flip(h_c, 1), jnp.flip(h_l, 1)
    return h_c, h_l


def merge_branches(a, b, r, gate_logits, w_proj_a, w_proj_b, w_proj_c, w_out, b_out):
    g_a, g_b, g_r = jnp.split(jax.nn.sigmoid(gate_logits), N_BRANCHES, axis=-1)
    y = g_a * (a @ w_proj_a) + g_b * (b @ w_proj_b) + g_r * (r @ w_proj_c)
    return y @ w_out + b_out


def token_mixer(h_lat, h_ctx, rope, w_in, b_in, sgu_ln_g, sgu_ln_b, w_spatial, b_spatial, attn_sink,
                conv_w, conv_b, w_rgate, b_rgate, w_igate, b_igate, lru_lambda,
                w_proj_a, w_proj_b, w_proj_c, w_out, b_out, need_ctx_out):
    q, u, v, gates, z, k, val, xr = split_cols(h_lat @ w_in + b_in, COL_WIDTHS)
    if need_ctx_out:
        q_c, u_c, v_c, gates_c, z_c, k_c, val_c, xr_c = split_cols(h_ctx @ w_in + b_in, COL_WIDTHS)
    else:
        k_c, val_c, xr_c = split_cols(h_ctx @ w_in[:, CTX_COL_OFF:] + b_in[CTX_COL_OFF:], COL_WIDTHS[-3:])

    def heads(t, nh):
        return t.reshape(t.shape[:2] + (nh, HEAD_DIM))

    a_lat = spatial_gating(jax.nn.gelu(u), jax.nn.gelu(v), sgu_ln_g, sgu_ln_b, w_spatial, b_spatial)
    k_cx, v_cx = heads(k_c, KV_HEADS), heads(val_c, KV_HEADS)
    b_lat = window_attention(apply_axial_rope(heads(q, ATT_HEADS), rope),
                             apply_axial_rope(heads(k, KV_HEADS), rope),
                             heads(val, KV_HEADS), k_cx, v_cx, attn_sink)
    hc_f, hl_f = rglru_direction(xr_c, xr, conv_w[0], conv_b[0], w_rgate[0], b_rgate[0],
                                 w_igate[0], b_igate[0], lru_lambda[0], reverse=False)
    hc_b, hl_b = rglru_direction(xr_c, xr, conv_w[1], conv_b[1], w_rgate[1], b_rgate[1],
                                 w_igate[1], b_igate[1], lru_lambda[1], reverse=True)
    r_lat = (hl_f + hl_b).astype(z.dtype) * jax.nn.gelu(z)
    y_lat = merge_branches(a_lat, b_lat, r_lat, gates, w_proj_a, w_proj_b, w_proj_c, w_out, b_out)
    if not need_ctx_out:
        return y_lat, None
    a_ctx = spatial_gating(jax.nn.gelu(u_c), jax.nn.gelu(v_c), sgu_ln_g, sgu_ln_b, w_spatial, b_spatial)
    b_ctx = context_attention(heads(q_c, ATT_HEADS), k_cx, v_cx, attn_sink)
    r_ctx = (hc_f + hc_b).astype(z_c.dtype) * jax.nn.gelu(z_c)
    y_ctx = merge_branches(a_ctx, b_ctx, r_ctx, gates_c, w_proj_a, w_proj_b, w_proj_c, w_out, b_out)
    return y_lat, y_ctx


def hierarchical_moe(h, w_group, b_group, w_router, b_router, w1, w3, w2):
    bsz, n, d = h.shape
    xt = h.reshape(-1, d)
    n_tok = xt.shape[0]
    g_logits = (xt @ w_group + b_group).astype(jnp.float32)
    g_idx = jnp.argmax(g_logits, axis=-1)
    g_w = jnp.take_along_axis(jax.nn.softmax(g_logits, axis=-1), g_idx[:, None], axis=-1)[:, 0]
    e_logits = (xt @ w_router + b_router).astype(jnp.float32).reshape(n_tok, N_GROUPS, EXPERTS_PER_GROUP)
    e_logits = jnp.take_along_axis(e_logits, g_idx[:, None, None], axis=1)[:, 0]
    top_v, top_j = lax.top_k(e_logits, TOP_K)
    gate = g_w[:, None] * jax.nn.softmax(top_v, axis=-1)
    expert = g_idx[:, None] * EXPERTS_PER_GROUP + top_j
    n_as = n_tok * TOP_K
    e_flat = expert.reshape(-1)
    order = jnp.argsort(e_flat)
    e_sorted = e_flat[order]
    tok_sorted = order // TOP_K
    gate_sorted = gate.reshape(-1)[order]
    counts = jnp.bincount(e_flat, length=N_EXPERTS)
    starts = jnp.cumsum(counts) - counts
    padded = (counts + MOE_BLOCK - 1) // MOE_BLOCK * MOE_BLOCK
    pad_ends = jnp.cumsum(padded)
    pad_starts = pad_ends - padded
    slot = pad_starts[e_sorted] + jnp.arange(n_as) - starts[e_sorted]
    n_slots = (-(-n_as // MOE_BLOCK) + N_EXPERTS) * MOE_BLOCK
    n_blocks = n_slots // MOE_BLOCK
    buf = jnp.zeros((n_slots, d), xt.dtype).at[slot].set(xt[tok_sorted])
    block_expert = jnp.minimum(
        jnp.searchsorted(pad_ends, jnp.arange(n_blocks) * MOE_BLOCK, side='right'), N_EXPERTS - 1)

    def expert_block(args):
        xb, e = args
        return (jax.nn.silu(xb @ w1[e]) * (xb @ w3[e])) @ w2[e]

    out = lax.map(expert_block, (buf.reshape(n_blocks, MOE_BLOCK, d), block_expert)).reshape(n_slots, d)
    contrib = out[slot] * gate_sorted[:, None].astype(out.dtype)
    y = jax.ops.segment_sum(contrib, tok_sorted, num_segments=n_tok)
    return y.reshape(bsz, n, d)


def setup_inputs(seed: int = 0) -> dict:
    key = jax.random.key(seed)
    keys = iter(jax.random.split(key, 48))
    f32 = jnp.float32
    L = DEPTH
    D = D_MODEL

    def nrm(shape, scale):
        return jax.random.normal(next(keys), shape, f32) * scale

    x = nrm((BATCH, SEQ, D), 1.0)
    c = nrm((BATCH, D), 1.0)
    ctx = nrm((BATCH, CTX_LEN, D), 1.0)
    c_ctx = nrm((D,), 1.0)
    w_mod = nrm((L, D, N_MOD * D), 0.5 * D ** -0.5)
    b_mod = nrm((L, N_MOD * D), 0.02)
    w_in = nrm((L, D, IN_W), D ** -0.5)
    b_in = nrm((L, IN_W), 0.02)
    sgu_ln_g = 1.0 + nrm((L, SGU_W), 0.02)
    sgu_ln_b = nrm((L, SGU_W), 0.02)
    w_spatial = nrm((L, SGU_GROUPS, CHUNK, CHUNK), CHUNK ** -0.5)
    b_spatial = 1.0 + nrm((L, SGU_GROUPS, CHUNK), 0.02)
    attn_sink = nrm((L, ATT_HEADS), 0.5)
    conv_w = nrm((L, 2, CONV_W, LRU_W), CONV_W ** -0.5)
    conv_b = nrm((L, 2, LRU_W), 0.02)
    w_rgate = nrm((L, 2, LRU_BLOCKS, LRU_BW, LRU_BW), LRU_BW ** -0.5)
    b_rgate = nrm((L, 2, LRU_W), 0.02)
    w_igate = nrm((L, 2, LRU_BLOCKS, LRU_BW, LRU_BW), LRU_BW ** -0.5)
    b_igate = nrm((L, 2, LRU_W), 0.02)
    a_pow = jax.random.uniform(next(keys), (L, 2, LRU_W), f32, 0.9, 0.999)
    a_base = a_pow ** (1.0 / LRU_C)
    lru_lambda = jnp.log(a_base) - jnp.log1p(-a_base)
    w_proj_a = nrm((L, SGU_W, D), SGU_W ** -0.5)
    w_proj_b = nrm((L, ATT_W, D), ATT_W ** -0.5)
    w_proj_c = nrm((L, LRU_W, D), LRU_W ** -0.5)
    w_out = nrm((L, D, D), BETA * D ** -0.5)
    b_out = nrm((L, D), 0.02)
    ln1_g = 1.0 + nrm((L, D), 0.02)
    ln1_b = nrm((L, D), 0.02)
    ln2_g = 1.0 + nrm((L, D), 0.02)
    ln2_b = nrm((L, D), 0.02)
    w_group = nrm((L, D, N_GROUPS), D ** -0.5)
    b_group = nrm((L, N_GROUPS), 0.01)
    w_router = nrm((L, D, N_EXPERTS), D ** -0.5)
    b_router = nrm((L, N_EXPERTS), 0.01)
    w1 = nrm((L, N_EXPERTS, D, D_EXPERT), D ** -0.5)
    w3 = nrm((L, N_EXPERTS, D, D_EXPERT), D ** -0.5)
    w2 = nrm((L, N_EXPERTS, D_EXPERT, D), BETA * D_EXPERT ** -0.5)
    return {'x': x, 'c': c, 'ctx': ctx, 'c_ctx': c_ctx, 'w_mod': w_mod, 'b_mod': b_mod,
            'w_in': w_in, 'b_in': b_in, 'sgu_ln_g': sgu_ln_g, 'sgu_ln_b': sgu_ln_b,
            'w_spatial': w_spatial, 'b_spatial': b_spatial, 'attn_sink': attn_sink,
            'conv_w': conv_w, 'conv_b': conv_b, 'w_rgate': w_rgate, 'b_rgate': b_rgate,
            'w_igate': w_igate, 'b_igate': b_igate, 'lru_lambda': lru_lambda,
            'w_proj_a': w_proj_a, 'w_proj_b': w_proj_b, 'w_proj_c': w_proj_c,
            'w_out': w_out, 'b_out': b_out, 'ln1_g': ln1_g, 'ln1_b': ln1_b,
            'ln2_g': ln2_g, 'ln2_b': ln2_b, 'w_group': w_group, 'b_group': b_group,
            'w_router': w_router, 'b_router': b_router, 'w1': w1, 'w3': w3, 'w2': w2}


def reference(x, c, ctx, c_ctx, w_mod, b_mod, w_in, b_in, sgu_ln_g, sgu_ln_b, w_spatial, b_spatial,
              attn_sink, conv_w, conv_b, w_rgate, b_rgate, w_igate, b_igate, lru_lambda,
              w_proj_a, w_proj_b, w_proj_c, w_out, b_out, ln1_g, ln1_b, ln2_g, ln2_b,
              w_group, b_group, w_router, b_router, w1, w3, w2):
    n_ctx = ctx.shape[1]
    rope = axial_rope_tables(x.shape[1])
    cond_lat = jax.nn.silu(c)
    cond_ctx = jax.nn.silu(c_ctx)
    for l in range(DEPTH):
        last = l == DEPTH - 1
        m_lat = [m[:, None, :] for m in jnp.split(cond_lat @ w_mod[l] + b_mod[l], N_MOD, axis=-1)]
        m_ctx = jnp.split(cond_ctx @ w_mod[l] + b_mod[l], N_MOD, axis=-1)
        y_lat, y_ctx = token_mixer(
            x * (1.0 + m_lat[1]) + m_lat[0], ctx * (1.0 + m_ctx[1]) + m_ctx[0], rope,
            w_in[l], b_in[l], sgu_ln_g[l], sgu_ln_b[l], w_spatial[l], b_spatial[l], attn_sink[l],
            conv_w[l], conv_b[l], w_rgate[l], b_rgate[l], w_igate[l], b_igate[l], lru_lambda[l],
            w_proj_a[l], w_proj_b[l], w_proj_c[l], w_out[l], b_out[l], need_ctx_out=not last)
        x = layer_norm(ALPHA * x + m_lat[2] * y_lat, ln1_g[l], ln1_b[l])
        h_lat = x * (1.0 + m_lat[4]) + m_lat[3]
        if last:
            f_lat = hierarchical_moe(h_lat, w_group[l], b_group[l], w_router[l], b_router[l],
                                     w1[l], w3[l], w2[l])
        else:
            ctx = layer_norm(ALPHA * ctx + m_ctx[2] * y_ctx, ln1_g[l], ln1_b[l])
            h_ctx = ctx * (1.0 + m_ctx[4]) + m_ctx[3]
            f_all = hierarchical_moe(jnp.concatenate([h_ctx, h_lat], axis=1), w_group[l], b_group[l],
                                     w_router[l], b_router[l], w1[l], w3[l], w2[l])
            f_lat = f_all[:, n_ctx:]
            ctx = layer_norm(ALPHA * ctx + m_ctx[5] * f_all[:, :n_ctx], ln2_g[l], ln2_b[l])
        x = layer_norm(ALPHA * x + m_lat[5] * f_lat, ln2_g[l], ln2_b[l])
    return x
```

```cpp
#ifndef CPU_SHIM
#include <hip/hip_runtime.h>
#define LAUNCH(k, grid, block, stream, ...) hipLaunchKernelGGL(k, dim3(grid), dim3(block), 0, stream, __VA_ARGS__)
#endif
#include <stdint.h>
#include <stddef.h>
#include <math.h>

#ifndef DBG_DUMP
#define DBG_DUMP(name, l, ptr, n)
#endif
namespace nv {
constexpr int D = 1024, NB = 2, CTX = 256, HD = 64, NH = 8, NKV = 2, ATT_W = 512, KV_W = 128, WIN = 128, CHUNK = 128;
constexpr int SGU_W = 512, SGU_GW = 128, LRU_W = 1024, LRU_BW = 128, NEXP = 32, EPG = 8, NGRP = 4, DEXP = 512, NMOD = 6;
constexpr int IN_W = 6912;
constexpr int OFF_Q = 0, OFF_U = 512, OFF_V = 1024, OFF_G = 1536, OFF_Z = 4608, OFF_K = 5632, OFF_VAL = 5760, OFF_XR = 5888;
constexpr float LN_EPS = 1e-6f;

struct Dims { int S, L, TPB, T, nslots, pad; };

__device__ __forceinline__ float sigmoidf_(float x) { return 1.0f / (1.0f + expf(-x)); }
__device__ __forceinline__ float siluf_(float x) { return x / (1.0f + expf(-x)); }
__device__ __forceinline__ float geluf_(float x) { return 0.5f * x * (1.0f + tanhf(0.7978845608028654f * (x + 0.044715f * x * x * x))); }
__device__ __forceinline__ size_t gtid() { return (size_t)blockIdx.x * blockDim.x + threadIdx.x; }

__global__ void nk_mod(const float* c, const float* c_ctx, const float* w_mod, const float* b_mod, float* MOD, Dims dm) {
    const size_t i = gtid(); if (i >= (size_t)dm.L * NMOD * D) return;
    const int l = (int)(i / (NMOD * D)), j = (int)(i % (NMOD * D));
    float a0 = 0.f, a1 = 0.f, a2 = 0.f;
    const float* w = w_mod + (size_t)l * D * NMOD * D + j;
    for (int k = 0; k < D; ++k) { const float wv = w[(size_t)k * NMOD * D]; a0 += siluf_(c[k]) * wv; a1 += siluf_(c[D + k]) * wv; a2 += siluf_(c_ctx[k]) * wv; }
    const float b = b_mod[(size_t)l * NMOD * D + j];
    float* m = MOD + (size_t)l * (NB + 1) * NMOD * D;
    m[j] = a0 + b; m[NMOD * D + j] = a1 + b; m[2 * NMOD * D + j] = a2 + b;
}
__global__ void nk_init_x(const float* x, const float* ctx, float* X, Dims dm) {
    const size_t i = gtid(); if (i >= (size_t)dm.T * D) return;
    const int t = (int)(i / D), d = (int)(i % D), b = t / dm.TPB, p = t % dm.TPB;
    X[i] = p < CTX ? ctx[((size_t)b * CTX + p) * D + d] : x[((size_t)b * dm.S + (p - CTX)) * D + d];
}
__global__ void nk_write_out(const float* X, float* out, Dims dm) {
    const size_t i = gtid(); if (i >= (size_t)NB * dm.S * D) return;
    const int r = (int)(i / D), d = (int)(i % D), b = r / dm.S, s = r % dm.S;
    out[i] = X[((size_t)b * dm.TPB + CTX + s) * D + d];
}
__global__ void nk_modulate(const float* X, const float* MODl, float* H, int shift, Dims dm) {
    const size_t i = gtid(); if (i >= (size_t)dm.T * D) return;
    const int t = (int)(i / D), d = (int)(i % D), b = t / dm.TPB, p = t % dm.TPB, row = p < CTX ? NB : b;
    const float* m = MODl + (size_t)row * NMOD * D;
    H[i] = X[i] * (1.0f + m[(shift + 1) * D + d]) + m[shift * D + d];
}
__global__ void nk_gemm(const float* A, int lda, const int* arow, const float* Bm, int ldb, size_t bstride, const int* blk_e,
                        const float* bias, float* C, int ldc, int M, int N, int K) {
    const size_t tid = gtid(); const int n4c = N / 4; if (tid >= (size_t)(M / 4) * n4c) return;
    const int n0 = (int)(tid % n4c) * 4, m0 = (int)(tid / n4c) * 4;
    const float* Bp = Bm + (blk_e ? (size_t)blk_e[m0 / 128] * bstride : (size_t)0) + n0;
    int r0 = m0, r1 = m0 + 1, r2 = m0 + 2, r3 = m0 + 3;
    if (arow) { r0 = arow[r0]; r1 = arow[r1]; r2 = arow[r2]; r3 = arow[r3]; }
    const float* a0 = A + (size_t)(r0 < 0 ? 0 : r0) * lda; const float* a1 = A + (size_t)(r1 < 0 ? 0 : r1) * lda;
    const float* a2 = A + (size_t)(r2 < 0 ? 0 : r2) * lda; const float* a3 = A + (size_t)(r3 < 0 ? 0 : r3) * lda;
    const float z0 = r0 < 0 ? 0.f : 1.f, z1 = r1 < 0 ? 0.f : 1.f, z2 = r2 < 0 ? 0.f : 1.f, z3 = r3 < 0 ? 0.f : 1.f;
    float c00 = 0, c01 = 0, c02 = 0, c03 = 0, c10 = 0, c11 = 0, c12 = 0, c13 = 0, c20 = 0, c21 = 0, c22 = 0, c23 = 0, c30 = 0, c31 = 0, c32 = 0, c33 = 0;
    for (int k = 0; k < K; ++k) {
        const float* bp = Bp + (size_t)k * ldb; const float b0 = bp[0], b1 = bp[1], b2 = bp[2], b3 = bp[3];
        const float x0 = a0[k] * z0, x1 = a1[k] * z1, x2 = a2[k] * z2, x3 = a3[k] * z3;
        c00 += x0 * b0; c01 += x0 * b1; c02 += x0 * b2; c03 += x0 * b3;
        c10 += x1 * b0; c11 += x1 * b1; c12 += x1 * b2; c13 += x1 * b3;
        c20 += x2 * b0; c21 += x2 * b1; c22 += x2 * b2; c23 += x2 * b3;
        c30 += x3 * b0; c31 += x3 * b1; c32 += x3 * b2; c33 += x3 * b3;
    }
    float q0 = 0, q1 = 0, q2 = 0, q3 = 0; if (bias) { q0 = bias[n0]; q1 = bias[n0 + 1]; q2 = bias[n0 + 2]; q3 = bias[n0 + 3]; }
    float* c = C + (size_t)m0 * ldc + n0;
    c[0] = c00 + q0; c[1] = c01 + q1; c[2] = c02 + q2; c[3] = c03 + q3; c += ldc;
    c[0] = c10 + q0; c[1] = c11 + q1; c[2] = c12 + q2; c[3] = c13 + q3; c += ldc;
    c[0] = c20 + q0; c[1] = c21 + q1; c[2] = c22 + q2; c[3] = c23 + q3; c += ldc;
    c[0] = c30 + q0; c[1] = c31 + q1; c[2] = c32 + q2; c[3] = c33 + q3;
}
__global__ void nk_sgu_ln(const float* P, const float* g, const float* b, float* VN, Dims dm) {
    const size_t t = gtid(); if (t >= (size_t)dm.T) return;
    const float* v = P + t * IN_W + OFF_V; float s = 0.f;
    for (int c = 0; c < SGU_W; ++c) s += geluf_(v[c]);
    const float mu = s / SGU_W; float q = 0.f;
    for (int c = 0; c < SGU_W; ++c) { const float d = geluf_(v[c]) - mu; q += d * d; }
    const float rstd = 1.0f / sqrtf(q / SGU_W + LN_EPS);
    for (int c = 0; c < SGU_W; ++c) VN[t * SGU_W + c] = (geluf_(v[c]) - mu) * rstd * g[c] + b[c];
}
__global__ void nk_sgu_mix(const float* P, const float* VN, const float* w_sp, const float* b_sp, float* AO, Dims dm) {
    const size_t i = gtid(); if (i >= (size_t)dm.T * SGU_W) return;
    const int t = (int)(i / SGU_W), col = (int)(i % SGU_W), g = col / SGU_GW, p = t % dm.TPB, pp = p % CHUNK; const size_t base = (size_t)t - pp;
    const float* w = w_sp + ((size_t)g * CHUNK + pp) * CHUNK; float acc = 0.f;
    for (int q = 0; q < CHUNK; ++q) acc += w[q] * VN[(base + q) * SGU_W + col];
    AO[i] = geluf_(P[(size_t)t * IN_W + OFF_U + col]) * (acc + b_sp[g * CHUNK + pp]);
}
__global__ void nk_rope(const float* P, float* QK, Dims dm) {
    const size_t i = gtid(); if (i >= (size_t)dm.T * 640) return;
    const int t = (int)(i / 640), j = (int)(i % 640), p = t % dm.TPB;
    const int src = j < 512 ? OFF_Q + j : OFF_K + (j - 512);
    const float* row = P + (size_t)t * IN_W;
    if (p < CTX) { QK[i] = row[src]; return; }
    const int pos = p - CTX, e = j & 63, half = e >> 5, f = e & 31, fi = f & 15;
    const float coord = (float)(half ? (pos % 64) : (pos / 64));
    const float inv = powf(10000.0f, -(float)(2 * fi) / 32.0f);
    const float ang = coord * inv, cs = cosf(ang), sn = sinf(ang);
    const int hb = src - e + half * 32;
    const float x1 = row[hb + fi], x2 = row[hb + 16 + fi];
    QK[i] = f < 16 ? (x1 * cs - x2 * sn) : (x2 * cs + x1 * sn);
}
__global__ void __launch_bounds__(64) nk_attn(const float* QK, const float* P, const float* sink, float* BO, Dims dm) {
    const size_t i = gtid(); if (i >= (size_t)dm.T * NH) return;
    const int t = (int)(i / NH), h = (int)(i % NH), kv = h / (NH / NKV), b = t / dm.TPB, p = t % dm.TPB;
    float q[HD], o[HD];
#pragma unroll
    for (int d = 0; d < HD; ++d) { q[d] = QK[(size_t)t * 640 + h * HD + d]; o[d] = 0.f; }
    float m = sink[h], l = 1.0f;
    const int tb = b * dm.TPB;
    int lo = 0, hi = -1;
    if (p >= CTX) { const int pos = p - CTX; lo = pos - WIN < 0 ? 0 : pos - WIN; hi = pos + WIN > dm.S - 1 ? dm.S - 1 : pos + WIN; }
    const int nloc = hi - lo + 1 > 0 ? hi - lo + 1 : 0;
    for (int jj = 0; jj < CTX + nloc; ++jj) {
        const int kt = tb + (jj < CTX ? jj : CTX + lo + (jj - CTX));
        const float* kr = QK + (size_t)kt * 640 + 512 + kv * HD; const float* vr = P + (size_t)kt * IN_W + OFF_VAL + kv * HD;
        float s = 0.f;
#pragma unroll
        for (int d = 0; d < HD; ++d) s += q[d] * kr[d];
        s *= 0.125f;
        if (s > m) { const float sc = expf(m - s); l *= sc;
#pragma unroll
            for (int d = 0; d < HD; ++d) o[d] *= sc;
            m = s; }
        const float pe = expf(s - m); l += pe;
#pragma unroll
        for (int d = 0; d < HD; ++d) o[d] += pe * vr[d];
    }
    const float il = 1.0f / l;
#pragma unroll
    for (int d = 0; d < HD; ++d) BO[(size_t)t * ATT_W + h * HD + d] = o[d] * il;
}
__device__ __forceinline__ float conv_at(const float* P, const float* cw, const float* cb, int dir, int b, int p, int ch, const Dims& dm) {
    const int s0 = p < CTX ? 0 : CTX, s1 = p < CTX ? CTX : dm.TPB;
    const float* w = cw + (size_t)dir * 4 * LRU_W + ch; float out = cb[dir * LRU_W + ch];
    const float* xp = P + (size_t)b * dm.TPB * IN_W + OFF_XR + ch;
#pragma unroll
    for (int j = 0; j < 4; ++j) { const int pp = dir ? p + j : p + j - 3; if (pp >= s0 && pp < s1) out += w[j * LRU_W] * xp[(size_t)pp * IN_W]; }
    return out;
}
__global__ void nk_lru_gates(const float* P, const float* cw, const float* cb, const float* wr, const float* br, const float* wi, const float* bi,
                             const float* lam, float* AA, float* UU, Dims dm) {
    const size_t i = gtid(); if (i >= (size_t)2 * dm.T * LRU_W) return;
    const int dir = (int)(i / ((size_t)dm.T * LRU_W)); const size_t rem = i % ((size_t)dm.T * LRU_W);
    const int t = (int)(rem / LRU_W), ch = (int)(rem % LRU_W), blk = ch / LRU_BW, dc = ch % LRU_BW, b = t / dm.TPB, p = t % dm.TPB;
    const float* wrp = wr + ((size_t)(dir * 8 + blk) * LRU_BW) * LRU_BW + dc; const float* wip = wi + ((size_t)(dir * 8 + blk) * LRU_BW) * LRU_BW + dc;
    float ar = 0.f, ai = 0.f;
    for (int c = 0; c < LRU_BW; ++c) { const float tv = conv_at(P, cw, cb, dir, b, p, blk * LRU_BW + c, dm); ar += tv * wrp[(size_t)c * LRU_BW]; ai += tv * wip[(size_t)c * LRU_BW]; }
    const float r = sigmoidf_(ar + br[dir * LRU_W + ch]), ig = sigmoidf_(ai + bi[dir * LRU_W + ch]);
    const float nl = -lam[dir * LRU_W + ch]; const float sp = nl > 20.f ? nl : log1pf(expf(nl));
    const float log_a = -8.0f * r * sp; const float a = expf(log_a); const float mult = sqrtf(-expm1f(2.0f * log_a));
    const float tv = conv_at(P, cw, cb, dir, b, p, ch, dm);
    AA[i] = a; UU[i] = mult * ig * tv;
}
__global__ void nk_lru_scan(const float* AA, float* UU, Dims dm) {
    const size_t i = gtid(); if (i >= (size_t)2 * NB * LRU_W) return;
    const int dir = (int)(i / (NB * LRU_W)), b = (int)((i / LRU_W) % NB), ch = (int)(i % LRU_W);
    const size_t base = ((size_t)dir * dm.T + (size_t)b * dm.TPB) * LRU_W + ch; float h = 0.f;
    if (!dir) { for (int p = 0; p < dm.TPB; ++p) { const size_t o = base + (size_t)p * LRU_W; h = AA[o] * h + UU[o]; UU[o] = h; } }
    else { for (int p = CTX - 1; p >= 0; --p) { const size_t o = base + (size_t)p * LRU_W; h = AA[o] * h + UU[o]; UU[o] = h; }
           for (int p = dm.TPB - 1; p >= CTX; --p) { const size_t o = base + (size_t)p * LRU_W; h = AA[o] * h + UU[o]; UU[o] = h; } }
}
__global__ void nk_lru_out(const float* P, const float* HH, float* RO, Dims dm) {
    const size_t i = gtid(); if (i >= (size_t)dm.T * LRU_W) return;
    const int t = (int)(i / LRU_W), ch = (int)(i % LRU_W);
    RO[i] = (HH[i] + HH[(size_t)dm.T * LRU_W + i]) * geluf_(P[(size_t)t * IN_W + OFF_Z + ch]);
}
__global__ void nk_merge(const float* P, const float* PA, const float* PB, const float* PC, float* Y, Dims dm) {
    const size_t i = gtid(); if (i >= (size_t)dm.T * D) return;
    const int t = (int)(i / D), n = (int)(i % D); const float* g = P + (size_t)t * IN_W + OFF_G + n;
    Y[i] = sigmoidf_(g[0]) * PA[i] + sigmoidf_(g[D]) * PB[i] + sigmoidf_(g[2 * D]) * PC[i];
}
__global__ void nk_ln_res(float* X, const float* Yv, const float* MODl, int gi, const float* g, const float* bb, float alpha, Dims dm) {
    const size_t t = gtid(); if (t >= (size_t)dm.T) return;
    const int b = (int)(t / dm.TPB), p = (int)(t % dm.TPB), row = p < CTX ? NB : b;
    const float* m = MODl + (size_t)row * NMOD * D + gi * D; float* x = X + t * D; const float* y = Yv + t * D;
    float s = 0.f; for (int d = 0; d < D; ++d) s += alpha * x[d] + m[d] * y[d];
    const float mu = s / D; float q = 0.f;
    for (int d = 0; d < D; ++d) { const float v = alpha * x[d] + m[d] * y[d] - mu; q += v * v; }
    const float rstd = 1.0f / sqrtf(q / D + LN_EPS);
    for (int d = 0; d < D; ++d) x[d] = (alpha * x[d] + m[d] * y[d] - mu) * rstd * g[d] + bb[d];
}
__global__ void nk_route(const float* H, const float* wg, const float* bg, const float* wrt, const float* brt, int* expert, float* gate, int* counts, Dims dm) {
    const size_t t = gtid(); if (t >= (size_t)dm.T) return;
    const float* h = H + t * D; float g0 = 0, g1 = 0, g2 = 0, g3 = 0;
    for (int k = 0; k < D; ++k) { const float hv = h[k]; const float* w = wg + (size_t)k * NGRP; g0 += hv * w[0]; g1 += hv * w[1]; g2 += hv * w[2]; g3 += hv * w[3]; }
    g0 += bg[0]; g1 += bg[1]; g2 += bg[2]; g3 += bg[3];
    int gi = 0; float gm = g0; if (g1 > gm) { gm = g1; gi = 1; } if (g2 > gm) { gm = g2; gi = 2; } if (g3 > gm) { gm = g3; gi = 3; }
    const float gw = 1.0f / (expf(g0 - gm) + expf(g1 - gm) + expf(g2 - gm) + expf(g3 - gm));
    float e0 = 0, e1 = 0, e2 = 0, e3 = 0, e4 = 0, e5 = 0, e6 = 0, e7 = 0;
    for (int k = 0; k < D; ++k) { const float hv = h[k]; const float* w = wrt + (size_t)k * NEXP + gi * EPG;
        e0 += hv * w[0]; e1 += hv * w[1]; e2 += hv * w[2]; e3 += hv * w[3]; e4 += hv * w[4]; e5 += hv * w[5]; e6 += hv * w[6]; e7 += hv * w[7]; }
    const float* bp = brt + gi * EPG;
    e0 += bp[0]; e1 += bp[1]; e2 += bp[2]; e3 += bp[3]; e4 += bp[4]; e5 += bp[5]; e6 += bp[6]; e7 += bp[7];
    int j0 = 0; float v0 = e0;
    if (e1 > v0) { v0 = e1; j0 = 1; } if (e2 > v0) { v0 = e2; j0 = 2; } if (e3 > v0) { v0 = e3; j0 = 3; } if (e4 > v0) { v0 = e4; j0 = 4; }
    if (e5 > v0) { v0 = e5; j0 = 5; } if (e6 > v0) { v0 = e6; j0 = 6; } if (e7 > v0) { v0 = e7; j0 = 7; }
    int j1 = -1; float v1 = -3.0e38f;
    if (j0 != 0 && e0 > v1) { v1 = e0; j1 = 0; } if (j0 != 1 && e1 > v1) { v1 = e1; j1 = 1; } if (j0 != 2 && e2 > v1) { v1 = e2; j1 = 2; } if (j0 != 3 && e3 > v1) { v1 = e3; j1 = 3; }
    if (j0 != 4 && e4 > v1) { v1 = e4; j1 = 4; } if (j0 != 5 && e5 > v1) { v1 = e5; j1 = 5; } if (j0 != 6 && e6 > v1) { v1 = e6; j1 = 6; } if (j0 != 7 && e7 > v1) { v1 = e7; j1 = 7; }
    const float p1 = expf(v1 - v0), inv = 1.0f / (1.0f + p1);
    expert[t * 2] = gi * EPG + j0; expert[t * 2 + 1] = gi * EPG + j1; gate[t * 2] = gw * inv; gate[t * 2 + 1] = gw * p1 * inv;
    atomicAdd(&counts[gi * EPG + j0], 1); atomicAdd(&counts[gi * EPG + j1], 1);
}
__global__ void nk_fill_int(int* p, int v, size_t n) { const size_t i = gtid(); if (i < n) p[i] = v; }
__global__ void nk_moe_offsets(const int* counts, int* pad_start, int* blk_e, int* fill, Dims dm) {
    if (gtid() != 0) return;
    int acc = 0;
    for (int e = 0; e < NEXP; ++e) { pad_start[e] = acc; fill[e] = 0; const int pc = (counts[e] + 127) / 128 * 128; for (int b = acc / 128; b < (acc + pc) / 128; ++b) blk_e[b] = e; acc += pc; }
    for (int b = acc / 128; b < dm.nslots / 128; ++b) blk_e[b] = NEXP - 1;
}
__global__ void nk_moe_scatter(const int* expert, const int* pad_start, int* fill, int* slot_of, int* tok_of_slot, Dims dm) {
    const size_t i = gtid(); if (i >= (size_t)dm.T * 2) return;
    const int e = expert[i]; const int pos = atomicAdd(&fill[e], 1); const int slot = pad_start[e] + pos;
    slot_of[i] = slot; tok_of_slot[slot] = (int)(i / 2);
}
__global__ void nk_swiglu(const float* G1, const float* G3, float* HH, size_t n) { const size_t i = gtid(); if (i < n) HH[i] = siluf_(G1[i]) * G3[i]; }
__global__ void nk_moe_combine(const float* O, const int* slot_of, const float* gate, float* F, Dims dm) {
    const size_t i = gtid(); if (i >= (size_t)dm.T * D) return;
    const int t = (int)(i / D), d = (int)(i % D);
    F[i] = gate[t * 2] * O[(size_t)slot_of[t * 2] * D + d] + gate[t * 2 + 1] * O[(size_t)slot_of[t * 2 + 1] * D + d];
}

struct In {
    const float *x, *c, *ctx, *c_ctx, *w_mod, *b_mod, *w_in, *b_in, *sgu_ln_g, *sgu_ln_b, *w_spatial, *b_spatial, *attn_sink, *conv_w, *conv_b,
        *w_rgate, *b_rgate, *w_igate, *b_igate, *lru_lambda, *w_proj_a, *w_proj_b, *w_proj_c, *w_out, *b_out, *ln1_g, *ln1_b, *ln2_g, *ln2_b,
        *w_group, *b_group, *w_router, *b_router, *w1, *w3, *w2;
};
static inline unsigned nblk(size_t n, int bs = 256) { return (unsigned)((n + bs - 1) / bs); }

static void gemm(hipStream_t st, const float* A, int lda, const int* arow, const float* B, int ldb, size_t bstride, const int* blk_e, const float* bias, float* C, int ldc, int M, int N, int K) {
    LAUNCH(nk_gemm, nblk((size_t)(M / 4) * (N / 4)), 256, st, A, lda, arow, B, ldb, bstride, blk_e, bias, C, ldc, M, N, K);
}

static void forward_naive(const In& in, float* out, char* ws, Dims dm, hipStream_t st) {
    const size_t T = dm.T;
    size_t off = 0; auto take = [&](size_t bytes) { char* p = ws + off; off += (bytes + 255) / 256 * 256; return p; };
    float* MOD = (float*)take((size_t)dm.L * (NB + 1) * NMOD * D * 4);
    float* X = (float*)take(T * D * 4);
    float* H = (float*)take(T * D * 4);
    float* AO = (float*)take(T * SGU_W * 4);
    float* BO = (float*)take(T * ATT_W * 4);
    float* RO = (float*)take(T * LRU_W * 4);
    int* expert = (int*)take(T * 2 * 4); float* gate = (float*)take(T * 2 * 4); int* slot_of = (int*)take(T * 2 * 4);
    int* tok_of_slot = (int*)take((size_t)dm.nslots * 4); int* counts = (int*)take(256); int* pad_start = (int*)take(256); int* fill = (int*)take(256);
    int* blk_e = (int*)take((size_t)(dm.nslots / 128) * 4);
    const size_t pbytes = T * IN_W * 4, mbytes = (size_t)dm.nslots * (3 * DEXP + D) * 4;
    float* P = (float*)take(pbytes > mbytes ? pbytes : mbytes);
    char* S1 = take(T * LRU_W * 4 * 4);
    float* AA = (float*)S1; float* UU = AA + 2 * T * LRU_W;
    float* VN = (float*)S1;
    float* QK = (float*)(S1 + T * SGU_W * 4);
    float* PA = (float*)S1; float* PB = PA + T * D; float* PC = PB + T * D; float* Y = PC + T * D;
    float* YO = PA;
    float* G1 = P; float* G3 = G1 + (size_t)dm.nslots * DEXP; float* HH = G3 + (size_t)dm.nslots * DEXP; float* O = HH + (size_t)dm.nslots * DEXP;
    float* F = (float*)S1;
    const float ALPHA = (float)pow(2.0 * dm.L, 0.25);

    LAUNCH(nk_mod, nblk((size_t)dm.L * NMOD * D), 256, st, in.c, in.c_ctx, in.w_mod, in.b_mod, MOD, dm);
    LAUNCH(nk_init_x, nblk(T * D), 256, st, in.x, in.ctx, X, dm);
    for (int l = 0; l < dm.L; ++l) {
        const float* MODl = MOD + (size_t)l * (NB + 1) * NMOD * D;
        LAUNCH(nk_modulate, nblk(T * D), 256, st, (const float*)X, MODl, H, 0, dm);
        gemm(st, H, D, nullptr, in.w_in + (size_t)l * D * IN_W, IN_W, 0, nullptr, in.b_in + (size_t)l * IN_W, P, IN_W, (int)T, IN_W, D);
        LAUNCH(nk_sgu_ln, nblk(T, 64), 64, st, (const float*)P, in.sgu_ln_g + l * SGU_W, in.sgu_ln_b + l * SGU_W, VN, dm);
        LAUNCH(nk_sgu_mix, nblk(T * SGU_W), 256, st, (const float*)P, (const float*)VN, in.w_spatial + (size_t)l * 4 * CHUNK * CHUNK, in.b_spatial + l * 4 * CHUNK, AO, dm);
        LAUNCH(nk_rope, nblk(T * 640), 256, st, (const float*)P, QK, dm);
        LAUNCH(nk_attn, nblk(T * NH, 64), 64, st, (const float*)QK, (const float*)P, in.attn_sink + l * NH, BO, dm);
        LAUNCH(nk_lru_gates, nblk(2 * T * LRU_W), 256, st, (const float*)P, in.conv_w + (size_t)l * 2 * 4 * LRU_W, in.conv_b + l * 2 * LRU_W,
               in.w_rgate + (size_t)l * 2 * 8 * LRU_BW * LRU_BW, in.b_rgate + l * 2 * LRU_W, in.w_igate + (size_t)l * 2 * 8 * LRU_BW * LRU_BW, in.b_igate + l * 2 * LRU_W,
               in.lru_lambda + l * 2 * LRU_W, AA, UU, dm);
        LAUNCH(nk_lru_scan, nblk(2 * NB * LRU_W, 64), 64, st, (const float*)AA, UU, dm);
        LAUNCH(nk_lru_out, nblk(T * LRU_W), 256, st, (const float*)P, (const float*)UU, RO, dm);
        gemm(st, AO, SGU_W, nullptr, in.w_proj_a + (size_t)l * SGU_W * D, D, 0, nullptr, nullptr, PA, D, (int)T, D, SGU_W);
        gemm(st, BO, ATT_W, nullptr, in.w_proj_b + (size_t)l * ATT_W * D, D, 0, nullptr, nullptr, PB, D, (int)T, D, ATT_W);
        gemm(st, RO, LRU_W, nullptr, in.w_proj_c + (size_t)l * LRU_W * D, D, 0, nullptr, nullptr, PC, D, (int)T, D, LRU_W);
        LAUNCH(nk_merge, nblk(T * D), 256, st, (const float*)P, (const float*)PA, (const float*)PB, (const float*)PC, Y, dm);
        gemm(st, Y, D, nullptr, in.w_out + (size_t)l * D * D, D, 0, nullptr, in.b_out + l * D, YO, D, (int)T, D, D);
        DBG_DUMP("AO", l, AO, T * SGU_W); DBG_DUMP("BO", l, BO, T * ATT_W); DBG_DUMP("RO", l, RO, T * LRU_W); DBG_DUMP("YO", l, YO, T * D);
        LAUNCH(nk_ln_res, nblk(T, 64), 64, st, X, (const float*)YO, MODl, 2, in.ln1_g + l * D, in.ln1_b + l * D, ALPHA, dm);
        DBG_DUMP("X1", l, X, T * D);
        LAUNCH(nk_modulate, nblk(T * D), 256, st, (const float*)X, MODl, H, 3, dm);
        LAUNCH(nk_fill_int, 1, 64, st, counts, 0, (size_t)NEXP);
        LAUNCH(nk_fill_int, nblk(dm.nslots), 256, st, tok_of_slot, -1, (size_t)dm.nslots);
        LAUNCH(nk_route, nblk(T, 64), 64, st, (const float*)H, in.w_group + (size_t)l * D * NGRP, in.b_group + l * NGRP, in.w_router + (size_t)l * D * NEXP, in.b_router + l * NEXP,
               expert, gate, counts, dm);
        LAUNCH(nk_moe_offsets, 1, 64, st, (const int*)counts, pad_start, blk_e, fill, dm);
        LAUNCH(nk_moe_scatter, nblk(T * 2), 256, st, (const int*)expert, (const int*)pad_start, fill, slot_of, tok_of_slot, dm);
        const size_t ws1 = (size_t)D * DEXP;
        gemm(st, H, D, tok_of_slot, in.w1 + (size_t)l * NEXP * ws1, DEXP, ws1, blk_e, nullptr, G1, DEXP, dm.nslots, DEXP, D);
        gemm(st, H, D, tok_of_slot, in.w3 + (size_t)l * NEXP * ws1, DEXP, ws1, blk_e, nullptr, G3, DEXP, dm.nslots, DEXP, D);
        LAUNCH(nk_swiglu, nblk((size_t)dm.nslots * DEXP), 256, st, (const float*)G1, (const float*)G3, HH, (size_t)dm.nslots * DEXP);
        gemm(st, HH, DEXP, nullptr, in.w2 + (size_t)l * NEXP * ws1, D, ws1, blk_e, nullptr, O, D, dm.nslots, D, DEXP);
        LAUNCH(nk_moe_combine, nblk(T * D), 256, st, (const float*)O, (const int*)slot_of, (const float*)gate, F, dm);
        DBG_DUMP("F", l, F, T * D);
        LAUNCH(nk_ln_res, nblk(T, 64), 64, st, X, (const float*)F, MODl, 5, in.ln2_g + l * D, in.ln2_b + l * D, ALPHA, dm);
        DBG_DUMP("X2", l, X, T * D);
    }
    LAUNCH(nk_write_out, nblk((size_t)NB * dm.S * D), 256, st, (const float*)X, out, dm);
}
}

extern "C" void kernel_launch(void* const* d_in, const int* in_sizes, int n_in, void* d_out, int out_size, void* d_ws, size_t ws_size, hipStream_t stream) {
    nv::In in;
    const float** f = (const float**)&in;
    for (int i = 0; i < 36; ++i) f[i] = (const float*)d_in[i];
    nv::Dims dm;
    dm.S = in_sizes[0] / (nv::NB * nv::D);
    dm.L = in_sizes[5] / (nv::NMOD * nv::D);
    dm.TPB = nv::CTX + dm.S; dm.T = nv::NB * dm.TPB;
    dm.nslots = ((dm.T * 2 + 127) / 128 + nv::NEXP) * 128; dm.pad = 0;
    nv::forward_naive(in, (float*)d_out, (char*)d_ws, dm, stream);
}
```

```cpp
#ifndef CPU_SHIM
#include <hip/hip_runtime.h>
#endif
#include <stdint.h>
#include <stddef.h>
#include <math.h>
#include <string.h>

#ifndef DBG_DUMP
#define DBG_DUMP(name, l, ptr, n)
#endif

#ifndef CPU_SHIM
#define XB_TMO      128
#define XB_XCNT(j)  (256  + 64 * (j))
#define XB_XSUB(j)  (1280 + 64 * (j))
#define XB_XGEN(j)  (2304 + 64 * (j))
#define XB_TOP      3328
#define XB_TOPGEN   3392
#define XCD_BAR_WORDS 3456
#define XB_SPIN_CAP (1u << 18)
#define LAS __attribute__((address_space(3)))

__device__ __forceinline__ unsigned xb_ld(unsigned* p)              { return __hip_atomic_load(p, __ATOMIC_RELAXED, __HIP_MEMORY_SCOPE_AGENT); }
__device__ __forceinline__ unsigned xb_add(unsigned* p, unsigned v) { return __hip_atomic_fetch_add(p, v, __ATOMIC_RELAXED, __HIP_MEMORY_SCOPE_AGENT); }
__device__ __forceinline__ unsigned xb_xcc_id() { return (unsigned)__builtin_amdgcn_s_getreg((3 << 11) | 20) & 0xFu; }
#define XB_SPIN(cond, bar) do { unsigned _sp = 0; while (cond) { __builtin_amdgcn_s_sleep(1); \
    if ((++_sp & 255u) == 0u) { if (xb_ld(&(bar)[XB_TMO])) break; if (_sp > XB_SPIN_CAP) { atomicAdd(&(bar)[XB_TMO], 1u); break; } } } } while (0)

struct XcdBarrier { unsigned* bar; unsigned x; volatile LAS unsigned* st; };

__device__ __forceinline__ XcdBarrier xcd_barrier_post(unsigned* bar, volatile LAS unsigned* st) {
    XcdBarrier b; b.bar = bar; b.x = xb_xcc_id(); b.st = st;
    if (threadIdx.x == 0) (void)xb_add(&bar[XB_XCNT(b.x)], 1u);
    return b;
}
__device__ __forceinline__ void xcd_barrier_complete(unsigned* bar, unsigned x, unsigned& nloc, unsigned& nx) {
    const unsigned G = gridDim.x * gridDim.y * gridDim.z;
    unsigned sum, cnt, mine, sp = 0u;
    for (;;) {
        sum = 0u; cnt = 0u; mine = 0u;
#pragma unroll
        for (unsigned j = 0; j < 16; ++j) { const unsigned c = xb_ld(&bar[XB_XCNT(j)]); sum += c; cnt += (c > 0u) ? 1u : 0u; mine = (j == x) ? c : mine; }
        if (sum == G) break;
        __builtin_amdgcn_s_sleep(1);
        if ((++sp & 255u) == 0u) { if (xb_ld(&bar[XB_TMO])) break; if (sp > XB_SPIN_CAP) { atomicAdd(&bar[XB_TMO], 1u); break; } }
    }
    nloc = mine > 0u ? mine : 1u; nx = cnt > 0u ? cnt : 1u;
}
__device__ __forceinline__ void xcd_barrier(const XcdBarrier& b) {
    asm volatile("s_waitcnt vmcnt(0)" ::: "memory");
    __syncthreads();
    if (threadIdx.x == 0) {
        unsigned* bar = b.bar;
        __builtin_amdgcn_s_waitcnt(0);
        unsigned nloc = b.st[0], nx = b.st[1];
        if (nloc == 0u) { xcd_barrier_complete(bar, b.x, nloc, nx); b.st[0] = nloc; b.st[1] = nx; }
        const unsigned old = xb_add(&bar[XB_XSUB(b.x)], 1u);
        const unsigned gen = old / nloc;
        if (old + 1u == (gen + 1u) * nloc) {
            __builtin_amdgcn_fence(__ATOMIC_RELEASE, "agent");
            asm volatile("s_waitcnt vmcnt(0)" ::: "memory");
            const unsigned og = xb_add(&bar[XB_TOP], 1u);
            const unsigned tg = og / nx;
            if (og + 1u == (tg + 1u) * nx) xb_add(&bar[XB_TOPGEN], 1u);
            else XB_SPIN(xb_ld(&bar[XB_TOPGEN]) == tg, bar);
            __builtin_amdgcn_fence(__ATOMIC_ACQUIRE, "agent");
            xb_add(&bar[XB_XGEN(b.x)], 1u);
            asm volatile("s_waitcnt vmcnt(0)" ::: "memory");
        } else {
            XB_SPIN(xb_ld(&bar[XB_XGEN(b.x)]) == gen, bar);
            __builtin_amdgcn_fence(__ATOMIC_ACQUIRE, "agent");
            asm volatile("s_waitcnt vmcnt(0)" ::: "memory");
        }
    }
    __syncthreads();
}
#endif

#ifndef CPU_SHIM
namespace pg8 {
#define PG8_LAS __attribute__((address_space(3)))
typedef unsigned short bf16_t;
typedef short bf16x8 __attribute__((ext_vector_type(8)));
typedef float f32x4 __attribute__((ext_vector_type(4)));
typedef float f32x2 __attribute__((ext_vector_type(2)));
typedef unsigned u32x4 __attribute__((ext_vector_type(4)));
typedef unsigned u32x2 __attribute__((ext_vector_type(2)));
constexpr int BM = 256, BK = 64, HALF = 128, HTB = HALF * BK * 2  , STAGE_BYTES = 8 * HTB, NXCD = 8, WGM = 8;

__host__ __device__ __forceinline__ int lds_byte(int r, int c) { const int st = (r >> 4) * 2 + (c >> 5), rr = r & 15, cc = c & 31, ob = rr * 64 + cc * 2; return st * 1024 + (ob ^ (((ob >> 9) & 1) << 5)); }
__host__ __device__ __forceinline__ void stage_rc(int b, int& R, int& C) { const int st = b / 1024, sb = b % 1024, swz = sb ^ (((sb >> 9) & 1) << 5); R = (st >> 1) * 16 + swz / 64; C = (st & 1) * 32 + (swz % 64) / 2; }
__host__ __device__ __forceinline__ int perm32(int rho) { const int n = rho >> 4, i = rho & 15; return 8 * (i >> 2) + 4 * n + (i & 3); }

template <class T, class... A> __device__ __forceinline__ T mk(A... a) { return T{a...}; }
struct Unit { int pm, pn, e, valid, ks; };
struct Gemm { const bf16_t* A; const bf16_t* Bt; int M, N, K, lda, ldb; };

struct StaticOrder {
    int nM, nN, nwg, G, c;
    __host__ __device__ void init(int M, int N, int G_, int c_) { nM = M / BM; nN = N / BM; nwg = nM * nN; G = G_; c = c_; }
    __host__ __device__ bool next(int i, Unit& u) const {
        const long L = (long)i * G + c; if (L >= nwg) return false;
        int wgid = (int)L; { const int q = nwg / NXCD, r = nwg % NXCD, xcd = wgid % NXCD, off = wgid / NXCD; wgid = (xcd < r ? xcd * (q + 1) : r * (q + 1) + (xcd - r) * q) + off; }
        const int nig = WGM * nN, gid = wgid / nig, fm = gid * WGM, gsz = (nM - fm) < WGM ? (nM - fm) : WGM;
        u.pm = fm + ((wgid % nig) % gsz); u.pn = (wgid % nig) / gsz; u.ks = 0; return true;
    }
    __device__ __forceinline__ void a_ready(const Unit&) const {}
    __device__ __forceinline__ void done(const Unit&) const {}
};
typedef __bf16 bf16x2n __attribute__((ext_vector_type(2)));
__device__ __forceinline__ unsigned cvt_pk_bf16(float lo, float hi) { const f32x2 v = {lo, hi}; return __builtin_bit_cast(unsigned, __builtin_convertvector(v, bf16x2n)); }

struct EpiF32 {
    static constexpr bool PERM = false, AFTER_DRAIN = false, LDS_AUX = false;
    float* C; int ldc; const float* bias;
    __device__ __forceinline__ void operator()(const f32x4 (&acc)[2][2][4][2], const Unit& u, int wr, int wc, int fr, int fq) const {
        const int row0 = u.pm * BM + wr * 64 + fr, col0 = u.pn * BM + wc * 32 + 4 * fq;
        f32x4 bv[2][2];
#pragma unroll
        for (int bj = 0; bj < 2; ++bj)
#pragma unroll
            for (int n = 0; n < 2; ++n) bv[bj][n] = bias ? *(const f32x4*)(bias + col0 + bj * HALF + n * 16) : (f32x4){0.f, 0.f, 0.f, 0.f};
#pragma unroll
        for (int ai = 0; ai < 2; ++ai)
#pragma unroll
            for (int m = 0; m < 4; ++m) { float* rowp = C + (size_t)(row0 + ai * HALF + m * 16) * ldc + col0;
#pragma unroll
                for (int bj = 0; bj < 2; ++bj)
#pragma unroll
                    for (int n = 0; n < 2; ++n) *(f32x4*)(rowp + bj * HALF + n * 16) = acc[ai][bj][m][n] + bv[bj][n]; }
    }
};
struct EpiBf16 {
    static constexpr bool PERM = true, AFTER_DRAIN = false, LDS_AUX = false;
    bf16_t* O0; int ldc; const float* bias; int pnmask; size_t ks_stride;
    __device__ __forceinline__ void operator()(const f32x4 (&acc)[2][2][4][2], const Unit& u, int wr, int wc, int fr, int fq) const {
        bf16_t* const O = O0 + (size_t)u.ks * ks_stride;
        const int row0 = u.pm * BM + wr * 64 + fr, col0 = (u.pn & pnmask) * BM + wc * 32 + 8 * fq;
        f32x4 bv[2][2];
#pragma unroll
        for (int bj = 0; bj < 2; ++bj)
#pragma unroll
            for (int n = 0; n < 2; ++n) bv[bj][n] = bias ? *(const f32x4*)(bias + col0 + bj * HALF + 4 * n) : (f32x4){0.f, 0.f, 0.f, 0.f};
#pragma unroll
        for (int ai = 0; ai < 2; ++ai)
#pragma unroll
            for (int m = 0; m < 4; ++m) { bf16_t* rowp = O + (size_t)(row0 + ai * HALF + m * 16) * ldc + col0;
#pragma unroll
                for (int bj = 0; bj < 2; ++bj) { const f32x4 v0 = acc[ai][bj][m][0] + bv[bj][0], v1 = acc[ai][bj][m][1] + bv[bj][1];
                    u32x4 w; w.x = cvt_pk_bf16(v0[0], v0[1]); w.y = cvt_pk_bf16(v0[2], v0[3]); w.z = cvt_pk_bf16(v1[0], v1[1]); w.w = cvt_pk_bf16(v1[2], v1[3]);
                    *(u32x4*)(rowp + bj * HALF) = w; } }
    }
};

template <int MODE> struct EpiMerge {
    static constexpr bool PERM = true, AFTER_DRAIN = false, LDS_AUX = false;
    const bf16_t* G; int ldg, goff; float* Yacc; bf16_t* Y; int ldy;
    __device__ __forceinline__ void operator()(const f32x4 (&acc)[2][2][4][2], const Unit& u, int wr, int wc, int fr, int fq) const {
        const int row0 = u.pm * BM + wr * 64 + fr, col0 = u.pn * BM + wc * 32 + 8 * fq;
#pragma unroll
        for (int ai = 0; ai < 2; ++ai)
#pragma unroll
            for (int m = 0; m < 4; ++m) { const size_t row = (size_t)(row0 + ai * HALF + m * 16);
#pragma unroll
                for (int bj = 0; bj < 2; ++bj) { const int col = col0 + bj * HALF;
                    const u32x4 gw = *(const u32x4*)(G + row * ldg + goff + col);
                    f32x4 g0, g1; g0.x = __uint_as_float(gw.x << 16); g0.y = __uint_as_float(gw.x & 0xffff0000u); g0.z = __uint_as_float(gw.y << 16); g0.w = __uint_as_float(gw.y & 0xffff0000u);
                    g1.x = __uint_as_float(gw.z << 16); g1.y = __uint_as_float(gw.z & 0xffff0000u); g1.z = __uint_as_float(gw.w << 16); g1.w = __uint_as_float(gw.w & 0xffff0000u);
                    f32x4 v0 = g0 * acc[ai][bj][m][0], v1 = g1 * acc[ai][bj][m][1];
                    float* yp = Yacc + row * ldy + col;
                    if (MODE >= 1) { v0 += *(const f32x4*)yp; v1 += *(const f32x4*)(yp + 4); }
                    if (MODE <= 1) { *(f32x4*)yp = v0; *(f32x4*)(yp + 4) = v1; }
                    else { u32x4 w; w.x = cvt_pk_bf16(v0[0], v0[1]); w.y = cvt_pk_bf16(v0[2], v0[3]); w.z = cvt_pk_bf16(v1[0], v1[1]); w.w = cvt_pk_bf16(v1[2], v1[3]); *(u32x4*)(Y + row * ldy + col) = w; } } }
    }
};
struct SliceOrder {
    StaticOrder T4; int G, c;
    __device__ __forceinline__ bool next(int i, Unit& u) const { const int L = i * G + c; StaticOrder one = T4; one.G = 1; one.c = 0; if (!one.next(L >> 2, u)) return false; u.ks = L & 3; return true; }
    __device__ __forceinline__ void a_ready(const Unit&) const {}
    __device__ __forceinline__ void done(const Unit&) const {}
};
struct LatentSliceOrder {
    int G, c, lg;
    __device__ __forceinline__ bool next(int i, Unit& u) const { const int L = i * G + c, tile = L >> lg; if (tile >= 256) return false; const int pmL = tile >> 2;
        u.pm = pmL + 1 + (pmL >= 32 ? 1 : 0); u.pn = tile & 3; u.ks = L & ((1 << lg) - 1); return true; }
    __device__ __forceinline__ void a_ready(const Unit&) const {}
    __device__ __forceinline__ void done(const Unit&) const {}
};
struct OneTileOrder {
    int pm, pn;
    __device__ __forceinline__ bool next(int i, Unit& u) const { if (i > 0) return false; u.pm = pm; u.pn = pn; u.ks = 0; return true; }
    __device__ __forceinline__ void a_ready(const Unit&) const {}
    __device__ __forceinline__ void done(const Unit&) const {}
};
struct EpiSwiglu {
    static constexpr bool PERM = true, AFTER_DRAIN = false, LDS_AUX = false;
    bf16_t* HH; int ldc;
    __device__ __forceinline__ void operator()(const f32x4 (&acc)[2][2][4][2], const Unit& u, int wr, int wc, int fr, int fq) const {
        const int row0 = u.pm * BM + wr * 64 + fr, col0 = (u.pn & 3) * HALF + wc * 32 + 8 * fq;
#pragma unroll
        for (int ai = 0; ai < 2; ++ai)
#pragma unroll
            for (int m = 0; m < 4; ++m) { float h[8];
#pragma unroll
                for (int n = 0; n < 2; ++n)
#pragma unroll
                    for (int j = 0; j < 4; ++j) { const float a = acc[ai][0][m][n][j], b = acc[ai][1][m][n][j]; h[4 * n + j] = a * __builtin_amdgcn_rcpf(1.0f + __expf(-a)) * b; }
                u32x4 w; w.x = cvt_pk_bf16(h[0], h[1]); w.y = cvt_pk_bf16(h[2], h[3]); w.z = cvt_pk_bf16(h[4], h[5]); w.w = cvt_pk_bf16(h[6], h[7]);
                *(u32x4*)(HH + (size_t)(row0 + ai * HALF + m * 16) * ldc + col0) = w; }
    }
};
struct MoeOrder {
    const PG8_LAS int* tst; const PG8_LAS int* cntl; const int* list; int cap, G, c;
    __device__ __forceinline__ bool next(int i, Unit& u) const {
        const int ntile = __builtin_amdgcn_readfirstlane(tst[32]); const int U = 4 * ntile, x = c & 7, lo = (x * U) >> 3, hi = ((x + 1) * U) >> 3;
        const int L = lo + (c >> 3) + (G >> 3) * i, q = L >> 2;
        if (L >= hi) return false;
        int e = 0;
        for (int k = 1; k < 32; ++k) e += (__builtin_amdgcn_readfirstlane(tst[k]) <= q) ? 1 : 0;
        const int r = q - __builtin_amdgcn_readfirstlane(tst[e]); const int left = __builtin_amdgcn_readfirstlane(cntl[e]) - 256 * r;
        u.pm = q; u.pn = 4 * e + (L & 3); u.e = e * cap + 256 * r; u.valid = left < 256 ? left : 256; u.ks = 0; return true;
    }
    __device__ __forceinline__ int row_tok(const Unit& u, int rr) const { return rr < u.valid ? list[u.e + rr] : 0; }
    __device__ __forceinline__ void a_ready(const Unit&) const {}
    __device__ __forceinline__ void done(const Unit&) const {}
};

template <class Epi, class Sched, bool GATHER = false>
__device__ __forceinline__ void gemm_phase(PG8_LAS unsigned char* lds, const Gemm g, const Sched& S, const Epi& E) {
    int tid_ = threadIdx.x; asm volatile("" : "+v"(tid_));
    const int tid = tid_, wid = __builtin_amdgcn_readfirstlane(tid >> 6), lane = tid & 63, wr = wid >> 2, wc = wid & 3, fr = lane & 15, fq = lane >> 4;
    const int K = g.K, nt = K / BK, lda = g.lda ? g.lda : K, ldb = g.ldb ? g.ldb : K;
    unsigned voffA[2], voffB[2];
#pragma unroll
    for (int i = 0; i < 2; ++i) { int R, C; stage_rc(tid * 16 + i * 8192, R, C); const int Rb = Epi::PERM ? ((R & ~31) + perm32(R & 31)) : R;
        voffA[i] = (unsigned)(R * lda + C) * 2u; voffB[i] = (unsigned)(Rb * ldb + C) * 2u; }
    const size_t kstep = (size_t)(BK * 2);
    const size_t hstepA = (size_t)HALF * lda * 2, hstepB = (size_t)HALF * ldb * 2;
    const size_t tstepA = 2 * hstepA, tstepB = 2 * hstepB, sstep = (size_t)K * 2;
    const unsigned ldsw = (unsigned)wid * 1024u;
    const int aoff = lds_byte(wr * 64 + fr, fq * 8), boff = lds_byte(wc * 32 + fr, fq * 8);
    int R0g, C0g; stage_rc(tid * 16, R0g, C0g);
    const char* const gA = (const char*)g.A;
    unsigned va_c[4] = {0u, 0u, 0u, 0u}, va_n[4] = {0u, 0u, 0u, 0u};
#define PG8_LOADIDX(dst, unit) do { _Pragma("unroll") for (int q_ = 0; q_ < 4; ++q_) dst[q_] = (unsigned)S.row_tok(unit, (q_ >> 1) * 128 + R0g + (q_ & 1) * 64) * (unsigned)(lda * 2) + (unsigned)(C0g * 2); } while (0)
#define PG8_STAGE_G(bufoff, kbytes, v0, v1) do { \
        __builtin_amdgcn_global_load_lds((const unsigned*)(gA + (kbytes) + (v0)), (PG8_LAS unsigned*)(lds + (bufoff) + ldsw), 16, 0, 0); \
        __builtin_amdgcn_global_load_lds((const unsigned*)(gA + (kbytes) + (v1)), (PG8_LAS unsigned*)(lds + (bufoff) + ldsw + 8192), 16, 0, 0); } while (0)
#define PG8_SA(b, h) (((b) * 2 + (h)) * HTB)
#define PG8_SB(b, h) ((4 + (b) * 2 + (h)) * HTB)
#define PG8_STAGE(bufoff, gbase, voff) do { _Pragma("unroll") for (int _i = 0; _i < 2; ++_i) \
        __builtin_amdgcn_global_load_lds((const unsigned*)((const char*)(gbase) + (voff)[_i]), (PG8_LAS unsigned*)(lds + (bufoff) + ldsw + _i * 8192), 16, 0, 0); } while (0)
#define PG8_LDA(dst, b, h) do { _Pragma("unroll") for (int m = 0; m < 4; ++m) _Pragma("unroll") for (int k = 0; k < 2; ++k) dst[m][k] = *(const PG8_LAS bf16x8*)(lds + PG8_SA(b, h) + aoff + m * 2048 + k * 1024); } while (0)
#define PG8_LDB(dst, b, h) do { _Pragma("unroll") for (int n = 0; n < 2; ++n) _Pragma("unroll") for (int k = 0; k < 2; ++k) dst[n][k] = *(const PG8_LAS bf16x8*)(lds + PG8_SB(b, h) + boff + n * 2048 + k * 1024); } while (0)
#define PG8_MMA(ai, bj, At, Bt) do { __builtin_amdgcn_s_setprio(1); _Pragma("unroll") for (int m = 0; m < 4; ++m) _Pragma("unroll") for (int n = 0; n < 2; ++n) _Pragma("unroll") for (int k = 0; k < 2; ++k) \
        acc[ai][bj][m][n] = __builtin_amdgcn_mfma_f32_16x16x32_bf16(Bt[n][k], At[m][k], acc[ai][bj][m][n], 0, 0, 0); __builtin_amdgcn_s_setprio(0); } while (0)
#define PG8_WAIT_V(n) asm volatile("s_waitcnt vmcnt(" #n ")" ::: "memory")
#define PG8_WAIT_L(n) asm volatile("s_waitcnt lgkmcnt(" #n ")" ::: "memory")
#define PG8_BAR __builtin_amdgcn_s_barrier()
#define PG8_SCHED __builtin_amdgcn_sched_barrier(0)
    Unit cur, nxt; int ui = 0;
    if (!S.next(0, cur)) return;
    f32x4 acc[2][2][4][2];
#pragma unroll
    for (int a = 0; a < 2; ++a)
#pragma unroll
        for (int b = 0; b < 2; ++b)
#pragma unroll
            for (int m = 0; m < 4; ++m)
#pragma unroll
                for (int n = 0; n < 2; ++n) acc[a][b][m][n] = (f32x4){0.f, 0.f, 0.f, 0.f};
    bf16x8 At[4][2], B0[2][2], B1[2][2];
    const char* cA = (const char*)g.A + (size_t)cur.pm * tstepA + (size_t)cur.ks * sstep; const char* cB = (const char*)g.Bt + (size_t)cur.pn * tstepB + (size_t)cur.ks * sstep;
    S.a_ready(cur);
    if constexpr (Epi::LDS_AUX) E.aux_dma(cur, 0, lane);
    bool has_next = S.next(1, nxt);
    if constexpr (GATHER) { PG8_LOADIDX(va_c, cur); if (has_next) PG8_LOADIDX(va_n, nxt); else { _Pragma("unroll") for (int q_ = 0; q_ < 4; ++q_) va_n[q_] = va_c[q_]; } }
    PG8_STAGE(PG8_SB(0, 0), cB, voffB);
    if constexpr (GATHER) PG8_STAGE_G(PG8_SA(0, 0), (size_t)0, va_c[0], va_c[1]); else PG8_STAGE(PG8_SA(0, 0), cA, voffA);
    PG8_STAGE(PG8_SB(0, 1), cB + hstepB, voffB);
    if constexpr (GATHER) PG8_STAGE_G(PG8_SA(0, 1), (size_t)0, va_c[2], va_c[3]); else PG8_STAGE(PG8_SA(0, 1), cA + hstepA, voffA);
    if (wr == 1) PG8_BAR;
    PG8_WAIT_V(4); PG8_BAR;
    PG8_STAGE(PG8_SB(1, 0), cB + kstep, voffB);
    if constexpr (GATHER) PG8_STAGE_G(PG8_SA(1, 0), kstep, va_c[0], va_c[1]); else PG8_STAGE(PG8_SA(1, 0), cA + kstep, voffA);
    PG8_STAGE(PG8_SB(1, 1), cB + hstepB + kstep, voffB);
    PG8_WAIT_V(6); PG8_BAR;
    for (;;) {
        const char* nA = has_next ? (const char*)g.A + (size_t)nxt.pm * tstepA + (size_t)nxt.ks * sstep : cA; const char* nB = has_next ? (const char*)g.Bt + (size_t)nxt.pn * tstepB + (size_t)nxt.ks * sstep : cB;
        for (int t = 0; t < nt; t += 2) {
            const bool last = (t == nt - 2);
            const char* a1 = cA + (size_t)(t + 1) * kstep;
            const char* a2 = last ? nA : cA + (size_t)(t + 2) * kstep; const char* b2 = last ? nB : cB + (size_t)(t + 2) * kstep;
            const char* a3 = a2 + kstep; const char* b3 = b2 + kstep;
            if (last && has_next) { S.a_ready(nxt); if constexpr (Epi::LDS_AUX) E.aux_dma(nxt, (ui + 1) & 1, lane); }
            const size_t k1 = (size_t)(t + 1) * kstep, k2 = last ? (size_t)0 : (size_t)(t + 2) * kstep, k3 = k2 + kstep;
            unsigned vs[4];
            if constexpr (GATHER) { _Pragma("unroll") for (int q_ = 0; q_ < 4; ++q_) vs[q_] = last ? va_n[q_] : va_c[q_]; }
            PG8_LDB(B0, 0, 0); PG8_SCHED; PG8_LDA(At, 0, 0); if constexpr (GATHER) PG8_STAGE_G(PG8_SA(1, 1), k1, va_c[2], va_c[3]); else PG8_STAGE(PG8_SA(1, 1), a1 + hstepA, voffA);
            PG8_WAIT_L(8); PG8_BAR; PG8_WAIT_L(0); PG8_MMA(0, 0, At, B0); PG8_BAR; PG8_SCHED;
            PG8_LDB(B1, 0, 1); PG8_STAGE(PG8_SB(0, 0), b2, voffB);
            PG8_BAR; PG8_WAIT_L(0); PG8_MMA(0, 1, At, B1); PG8_BAR;
            PG8_LDA(At, 0, 1); if constexpr (GATHER) PG8_STAGE_G(PG8_SA(0, 0), k2, vs[0], vs[1]); else PG8_STAGE(PG8_SA(0, 0), a2, voffA);
            PG8_BAR; PG8_WAIT_L(0); PG8_MMA(1, 0, At, B0); PG8_BAR; PG8_SCHED;
            PG8_STAGE(PG8_SB(0, 1), b2 + hstepB, voffB);
            PG8_WAIT_V(6); PG8_BAR; PG8_MMA(1, 1, At, B1); PG8_BAR;
            PG8_LDB(B0, 1, 0); PG8_SCHED; PG8_LDA(At, 1, 0); if constexpr (GATHER) PG8_STAGE_G(PG8_SA(0, 1), k2, vs[2], vs[3]); else PG8_STAGE(PG8_SA(0, 1), a2 + hstepA, voffA);
            PG8_WAIT_L(8); PG8_BAR; PG8_WAIT_L(0); PG8_MMA(0, 0, At, B0); PG8_BAR; PG8_SCHED;
            PG8_LDB(B1, 1, 1); PG8_STAGE(PG8_SB(1, 0), b3, voffB);
            PG8_BAR; PG8_WAIT_L(0); PG8_MMA(0, 1, At, B1); PG8_BAR;
            PG8_LDA(At, 1, 1); if constexpr (GATHER) PG8_STAGE_G(PG8_SA(1, 0), k3, vs[0], vs[1]); else PG8_STAGE(PG8_SA(1, 0), a3, voffA);
            PG8_BAR; PG8_WAIT_L(0); PG8_MMA(1, 0, At, B0); PG8_BAR; PG8_SCHED;
            PG8_STAGE(PG8_SB(1, 1), b3 + hstepB, voffB);
            PG8_WAIT_V(6); PG8_BAR; PG8_MMA(1, 1, At, B1); PG8_BAR;
        }
        if constexpr (Epi::LDS_AUX) { E(acc, cur, wr, wc, fr, fq, ui & 1); S.done(cur); }
        else if constexpr (!Epi::AFTER_DRAIN) { E(acc, cur, wr, wc, fr, fq); S.done(cur); }
        if (!has_next) break;
#pragma unroll
        for (int a = 0; a < 2; ++a)
#pragma unroll
            for (int b = 0; b < 2; ++b)
#pragma unroll
                for (int m = 0; m < 4; ++m)
#pragma unroll
                    for (int n = 0; n < 2; ++n) acc[a][b][m][n] = (f32x4){0.f, 0.f, 0.f, 0.f};
        cur = nxt; cA = nA; cB = nB; ++ui;
        has_next = S.next(ui + 1, nxt);
        if constexpr (GATHER) { _Pragma("unroll") for (int q_ = 0; q_ < 4; ++q_) va_c[q_] = va_n[q_]; if (has_next) PG8_LOADIDX(va_n, nxt); }
    }
    PG8_WAIT_V(0);
    if (wr == 0) PG8_BAR;
    PG8_BAR;
    if constexpr (Epi::AFTER_DRAIN) { E.fused(acc, cur, wr, wc, fr, fq, lds, wid, lane); S.done(cur); }
#undef PG8_SA
#undef PG8_SB
#undef PG8_STAGE
#undef PG8_STAGE_G
#undef PG8_LOADIDX
#undef PG8_LDA
#undef PG8_LDB
#undef PG8_MMA
#undef PG8_WAIT_V
#undef PG8_WAIT_L
#undef PG8_BAR
#undef PG8_SCHED
}
}
#endif

namespace nv {
constexpr int D = 1024, NB = 2, CTX = 256, HD = 64, NH = 8, NKV = 2, ATT_W = 512, KV_W = 128, WIN = 128, CHUNK = 128;
constexpr int SGU_W = 512, SGU_GW = 128, LRU_W = 1024, LRU_BW = 128, NEXP = 32, EPG = 8, NGRP = 4, DEXP = 512, NMOD = 6;
constexpr int IN_W = 6912;
constexpr int OFF_Q = 0, OFF_U = 512, OFF_V = 1024, OFF_G = 1536, OFF_Z = 4608, OFF_K = 5632, OFF_VAL = 5760, OFF_XR = 5888;
constexpr float LN_EPS = 1e-6f;
constexpr int ABR_LD = 2 * D;
constexpr int CNT_STRIDE = 64;

#ifdef CPU_SHIM
struct Dims { int S, L, TPB, T, nslots, pad; };
#else
struct Dims { static constexpr int S = 8192, L = 4, TPB = CTX + S, T = NB * TPB, nslots = ((T * 2 + 127) / 128 + NEXP) * 128; int pad0, pad1; };
#endif

__device__ __forceinline__ float sigmoidf_(float x) { return 1.0f / (1.0f + expf(-x)); }
__device__ __forceinline__ float siluf_(float x) { return x / (1.0f + expf(-x)); }
__device__ __forceinline__ float geluf_(float x) { return 0.5f * x * (1.0f + tanhf(0.7978845608028654f * (x + 0.044715f * x * x * x))); }

typedef unsigned short bf16_t;
#ifdef CPU_SHIM
__host__ __device__ __forceinline__ bf16_t f2bf(float f) { unsigned u; memcpy(&u, &f, 4); u += 0x7fffu + ((u >> 16) & 1u); return (bf16_t)(u >> 16); }
#else
__device__ __forceinline__ unsigned cvt_pk_bf16(float lo, float hi) { return pg8::cvt_pk_bf16(lo, hi); }
__device__ __forceinline__ bf16_t f2bf(float f) { return (bf16_t)(cvt_pk_bf16(f, f) & 0xffffu); }
#endif
__host__ __device__ __forceinline__ float bf2f(bf16_t b) { unsigned u = ((unsigned)b) << 16; float f; memcpy(&f, &u, 4); return f; }

__device__ __forceinline__ void d_mod(size_t i, const float* c, const float* c_ctx, const float* w_mod, const float* b_mod, float* MOD, const Dims& dm) {
    const int l = (int)(i / (NMOD * D)), j = (int)(i % (NMOD * D));
    float a0 = 0.f, a1 = 0.f, a2 = 0.f;
    const float* w = w_mod + (size_t)l * D * NMOD * D + j;
    for (int k = 0; k < D; ++k) { const float wv = w[(size_t)k * NMOD * D]; a0 += siluf_(c[k]) * wv; a1 += siluf_(c[D + k]) * wv; a2 += siluf_(c_ctx[k]) * wv; }
    const float b = b_mod[(size_t)l * NMOD * D + j];
    float* m = MOD + (size_t)l * (NB + 1) * NMOD * D;
    m[j] = a0 + b; m[NMOD * D + j] = a1 + b; m[2 * NMOD * D + j] = a2 + b;
}
__device__ __forceinline__ void d_init_x(size_t i, const float* x, const float* ctx, float* X, const Dims& dm) {
    const int t = (int)(i / D), d = (int)(i % D), b = t / dm.TPB, p = t % dm.TPB;
    X[i] = p < CTX ? ctx[((size_t)b * CTX + p) * D + d] : x[((size_t)b * dm.S + (p - CTX)) * D + d];
}
__device__ __forceinline__ void d_write_out(size_t i, const float* X, float* out, const Dims& dm) {
    const int r = (int)(i / D), d = (int)(i % D), b = r / dm.S, s = r % dm.S;
    out[i] = X[((size_t)b * dm.TPB + CTX + s) * D + d];
}
__device__ __forceinline__ void d_modulate(size_t i, const float* X, const float* MODl, float* H, int shift, const Dims& dm) {
    const int t = (int)(i / D), d = (int)(i % D), b = t / dm.TPB, p = t % dm.TPB, row = p < CTX ? NB : b;
    const float* m = MODl + (size_t)row * NMOD * D;
    H[i] = X[i] * (1.0f + m[(shift + 1) * D + d]) + m[shift * D + d];
}
__device__ __forceinline__ void d_modulate_bf(size_t i, const float* X, const float* MODl, bf16_t* H, int shift, const Dims& dm) {
    const int t = (int)(i / D), d = (int)(i % D), b = t / dm.TPB, p = t % dm.TPB, row = p < CTX ? NB : b;
    const float* m = MODl + (size_t)row * NMOD * D;
    H[i] = f2bf(X[i] * (1.0f + m[(shift + 1) * D + d]) + m[shift * D + d]);
}
__device__ __forceinline__ void d_gemm_ref(size_t i, const bf16_t* A, int lda, const float* W, int ldb, const float* bias, float* Cf, bf16_t* Cb, int ldc, int N, int K) {
    const size_t m = i / N; const int n = (int)(i % N); float acc = 0.f;
    for (int k = 0; k < K; ++k) acc += bf2f(A[m * lda + k]) * bf2f(f2bf(W[(size_t)k * ldb + n]));
    if (bias) acc += bias[n];
    if (Cf) Cf[m * ldc + n] = acc; else Cb[m * ldc + n] = f2bf(acc);
}
__device__ __forceinline__ void d_gemm(size_t tid, const float* A, int lda, const int* arow, const float* Bm, int ldb, size_t bstride, const int* blk_e,
                                       const float* bias, float* C, int ldc, int M, int N, int K) {
    const int n4c = N / 4;
    const int n0 = (int)(tid % n4c) * 4, m0 = (int)(tid / n4c) * 4;
    const float* Bp = Bm + (blk_e ? (size_t)blk_e[m0 / 128] * bstride : (size_t)0) + n0;
    int r0 = m0, r1 = m0 + 1, r2 = m0 + 2, r3 = m0 + 3;
    if (arow) { r0 = arow[r0]; r1 = arow[r1]; r2 = arow[r2]; r3 = arow[r3]; }
    const float* a0 = A + (size_t)(r0 < 0 ? 0 : r0) * lda; const float* a1 = A + (size_t)(r1 < 0 ? 0 : r1) * lda;
    const float* a2 = A + (size_t)(r2 < 0 ? 0 : r2) * lda; const float* a3 = A + (size_t)(r3 < 0 ? 0 : r3) * lda;
    const float z0 = r0 < 0 ? 0.f : 1.f, z1 = r1 < 0 ? 0.f : 1.f, z2 = r2 < 0 ? 0.f : 1.f, z3 = r3 < 0 ? 0.f : 1.f;
    float c00 = 0, c01 = 0, c02 = 0, c03 = 0, c10 = 0, c11 = 0, c12 = 0, c13 = 0, c20 = 0, c21 = 0, c22 = 0, c23 = 0, c30 = 0, c31 = 0, c32 = 0, c33 = 0;
    for (int k = 0; k < K; ++k) {
        const float* bp = Bp + (size_t)k * ldb; const float b0 = bp[0], b1 = bp[1], b2 = bp[2], b3 = bp[3];
        const float x0 = a0[k] * z0, x1 = a1[k] * z1, x2 = a2[k] * z2, x3 = a3[k] * z3;
        c00 += x0 * b0; c01 += x0 * b1; c02 += x0 * b2; c03 += x0 * b3;
        c10 += x1 * b0; c11 += x1 * b1; c12 += x1 * b2; c13 += x1 * b3;
        c20 += x2 * b0; c21 += x2 * b1; c22 += x2 * b2; c23 += x2 * b3;
        c30 += x3 * b0; c31 += x3 * b1; c32 += x3 * b2; c33 += x3 * b3;
    }
    float q0 = 0, q1 = 0, q2 = 0, q3 = 0; if (bias) { q0 = bias[n0]; q1 = bias[n0 + 1]; q2 = bias[n0 + 2]; q3 = bias[n0 + 3]; }
    float* c = C + (size_t)m0 * ldc + n0;
    c[0] = c00 + q0; c[1] = c01 + q1; c[2] = c02 + q2; c[3] = c03 + q3; c += ldc;
    c[0] = c10 + q0; c[1] = c11 + q1; c[2] = c12 + q2; c[3] = c13 + q3; c += ldc;
    c[0] = c20 + q0; c[1] = c21 + q1; c[2] = c22 + q2; c[3] = c23 + q3; c += ldc;
    c[0] = c30 + q0; c[1] = c31 + q1; c[2] = c32 + q2; c[3] = c33 + q3;
}
__device__ __forceinline__ void d_sgu_ln(size_t t, const bf16_t* P, const float* g, const float* b, float* VN, const Dims& dm) {
    const bf16_t* v = P + t * IN_W + OFF_V; float s = 0.f;
    for (int c = 0; c < SGU_W; ++c) s += bf2f(v[c]);
    const float mu = s / SGU_W; float q = 0.f;
    for (int c = 0; c < SGU_W; ++c) { const float d = bf2f(v[c]) - mu; q += d * d; }
    const float rstd = 1.0f / sqrtf(q / SGU_W + LN_EPS);
    for (int c = 0; c < SGU_W; ++c) VN[t * SGU_W + c] = (bf2f(v[c]) - mu) * rstd * g[c] + b[c];
}
__device__ __forceinline__ void d_sgu_mix(size_t i, const bf16_t* P, const float* VN, const float* w_sp, const float* b_sp, bf16_t* AO, const Dims& dm) {
    const int t = (int)(i / SGU_W), col = (int)(i % SGU_W), g = col / SGU_GW, p = t % dm.TPB, pp = p % CHUNK; const size_t base = (size_t)t - pp;
    const float* w = w_sp + ((size_t)g * CHUNK + pp) * CHUNK; float acc = 0.f;
    for (int q = 0; q < CHUNK; ++q) acc += w[q] * VN[(base + q) * SGU_W + col];
    AO[(size_t)t * ABR_LD + col] = f2bf(bf2f(P[(size_t)t * IN_W + OFF_U + col]) * (acc + b_sp[g * CHUNK + pp]));
}
__device__ __forceinline__ void d_rope(size_t i, const bf16_t* P, float* QK, const Dims& dm) {
    const int t = (int)(i / 640), j = (int)(i % 640), p = t % dm.TPB;
    const int src = j < 512 ? OFF_Q + j : OFF_K + (j - 512);
    const bf16_t* row = P + (size_t)t * IN_W;
    if (p < CTX) { QK[i] = bf2f(row[src]); return; }
    const int pos = p - CTX, e = j & 63, half = e >> 5, f = e & 31, fi = f & 15;
    const float coord = (float)(half ? (pos % 64) : (pos / 64));
    const float inv = powf(10000.0f, -(float)(2 * fi) / 32.0f);
    const float ang = coord * inv, cs = cosf(ang), sn = sinf(ang);
    const int hb = src - e + half * 32;
    const float x1 = bf2f(row[hb + fi]), x2 = bf2f(row[hb + 16 + fi]);
    QK[i] = f < 16 ? (x1 * cs - x2 * sn) : (x2 * cs + x1 * sn);
}
__device__ __forceinline__ void d_attn(size_t i, const float* QK, const bf16_t* P, const float* sink, bf16_t* BO, const Dims& dm) {
    const int t = (int)(i / NH), h = (int)(i % NH), kv = h / (NH / NKV), b = t / dm.TPB, p = t % dm.TPB;
    float q[HD], o[HD];
#pragma unroll
    for (int d = 0; d < HD; ++d) { q[d] = QK[(size_t)t * 640 + h * HD + d]; o[d] = 0.f; }
    float m = sink[h], l = 1.0f;
    const int tb = b * dm.TPB;
    int lo = 0, hi = -1;
    if (p >= CTX) { const int pos = p - CTX; lo = pos - WIN < 0 ? 0 : pos - WIN; hi = pos + WIN > dm.S - 1 ? dm.S - 1 : pos + WIN; }
    const int nloc = hi - lo + 1 > 0 ? hi - lo + 1 : 0;
    for (int jj = 0; jj < CTX + nloc; ++jj) {
        const int kt = tb + (jj < CTX ? jj : CTX + lo + (jj - CTX));
        const float* kr = QK + (size_t)kt * 640 + 512 + kv * HD; const bf16_t* vr = P + (size_t)kt * IN_W + OFF_VAL + kv * HD;
        float s = 0.f;
#pragma unroll
        for (int d = 0; d < HD; ++d) s += q[d] * kr[d];
        s *= 0.125f;
        if (s > m) { const float sc = expf(m - s); l *= sc;
#pragma unroll
            for (int d = 0; d < HD; ++d) o[d] *= sc;
            m = s; }
        const float pe = expf(s - m); l += pe;
#pragma unroll
        for (int d = 0; d < HD; ++d) o[d] += pe * bf2f(vr[d]);
    }
    const float il = 1.0f / l;
#pragma unroll
    for (int d = 0; d < HD; ++d) BO[(size_t)t * ATT_W + h * HD + d] = f2bf(o[d] * il);
}
__device__ __forceinline__ float conv_at(const bf16_t* P, const float* cw, const float* cb, int dir, int b, int p, int ch, const Dims& dm) {
    const int s0 = p < CTX ? 0 : CTX, s1 = p < CTX ? CTX : dm.TPB;
    const float* w = cw + (size_t)dir * 4 * LRU_W + ch; float out = cb[dir * LRU_W + ch];
    const bf16_t* xp = P + (size_t)b * dm.TPB * IN_W + OFF_XR + ch;
#pragma unroll
    for (int j = 0; j < 4; ++j) { const int pp = dir ? p + j : p + j - 3; if (pp >= s0 && pp < s1) out += w[j * LRU_W] * bf2f(xp[(size_t)pp * IN_W]); }
    return out;
}
__device__ __forceinline__ void d_lru_gates(size_t i, const bf16_t* P, const float* cw, const float* cb, const float* wr, const float* br, const float* wi, const float* bi,
                                            const float* lam, float* AA, float* UU, const Dims& dm) {
    const int dir = (int)(i / ((size_t)dm.T * LRU_W)); const size_t rem = i % ((size_t)dm.T * LRU_W);
    const int t = (int)(rem / LRU_W), ch = (int)(rem % LRU_W), blk = ch / LRU_BW, dc = ch % LRU_BW, b = t / dm.TPB, p = t % dm.TPB;
    const float* wrp = wr + ((size_t)(dir * 8 + blk) * LRU_BW) * LRU_BW + dc; const float* wip = wi + ((size_t)(dir * 8 + blk) * LRU_BW) * LRU_BW + dc;
    float ar = 0.f, ai = 0.f;
    for (int c = 0; c < LRU_BW; ++c) { const float tv = conv_at(P, cw, cb, dir, b, p, blk * LRU_BW + c, dm); ar += tv * wrp[(size_t)c * LRU_BW]; ai += tv * wip[(size_t)c * LRU_BW]; }
    const float r = sigmoidf_(ar + br[dir * LRU_W + ch]), ig = sigmoidf_(ai + bi[dir * LRU_W + ch]);
    const float nl = -lam[dir * LRU_W + ch]; const float sp = nl > 20.f ? nl : log1pf(expf(nl));
    const float log_a = -8.0f * r * sp; const float a = expf(log_a); const float mult = sqrtf(-expm1f(2.0f * log_a));
    const float tv = conv_at(P, cw, cb, dir, b, p, ch, dm);
    AA[i] = a; UU[i] = mult * ig * tv;
}
__device__ __forceinline__ void d_lru_scan(size_t i, const float* AA, float* UU, const Dims& dm) {
    const int dir = (int)(i / (NB * LRU_W)), b = (int)((i / LRU_W) % NB), ch = (int)(i % LRU_W);
    const size_t base = ((size_t)dir * dm.T + (size_t)b * dm.TPB) * LRU_W + ch; float h = 0.f;
    if (!dir) {
#pragma unroll 8
        for (int p = 0; p < dm.TPB; ++p) { const size_t o = base + (size_t)p * LRU_W; h = AA[o] * h + UU[o]; UU[o] = h; }
    } else {
#pragma unroll 8
        for (int p = CTX - 1; p >= 0; --p) { const size_t o = base + (size_t)p * LRU_W; h = AA[o] * h + UU[o]; UU[o] = h; }
#pragma unroll 8
        for (int p = dm.TPB - 1; p >= CTX; --p) { const size_t o = base + (size_t)p * LRU_W; h = AA[o] * h + UU[o]; UU[o] = h; }
    }
}
__device__ __forceinline__ void d_lru_out(size_t i, const bf16_t* P, const float* HH, bf16_t* RO, const Dims& dm) {
    const int t = (int)(i / LRU_W), ch = (int)(i % LRU_W);
    RO[i] = f2bf((HH[i] + HH[(size_t)dm.T * LRU_W + i]) * geluf_(bf2f(P[(size_t)t * IN_W + OFF_Z + ch])));
}
__device__ __forceinline__ void d_merge(size_t i, const bf16_t* P, const float* PA, const float* PB, const float* PC, bf16_t* Y, const Dims& dm) {
    const int t = (int)(i / D), n = (int)(i % D); const bf16_t* g = P + (size_t)t * IN_W + OFF_G + n;
    Y[i] = f2bf(bf2f(g[0]) * PA[i] + bf2f(g[D]) * PB[i] + bf2f(g[2 * D]) * PC[i]);
}
__device__ __forceinline__ void d_ln_res(size_t t, float* X, const float* Yv, const float* MODl, int gi, const float* g, const float* bb, float alpha, const Dims& dm) {
    const int b = (int)(t / dm.TPB), p = (int)(t % dm.TPB), row = p < CTX ? NB : b;
    const float* m = MODl + (size_t)row * NMOD * D + gi * D; float* x = X + t * D; const float* y = Yv + t * D;
    float s = 0.f; for (int d = 0; d < D; ++d) s += alpha * x[d] + m[d] * y[d];
    const float mu = s / D; float q = 0.f;
    for (int d = 0; d < D; ++d) { const float v = alpha * x[d] + m[d] * y[d] - mu; q += v * v; }
    const float rstd = 1.0f / sqrtf(q / D + LN_EPS);
    for (int d = 0; d < D; ++d) x[d] = (alpha * x[d] + m[d] * y[d] - mu) * rstd * g[d] + bb[d];
}
__device__ __forceinline__ void d_route(size_t t, const float* H, const float* wg, const float* bg, const float* wrt, const float* brt, int* expert, float* gate, int* counts, const Dims& dm) {
    const float* h = H + t * D; float g0 = 0, g1 = 0, g2 = 0, g3 = 0;
    for (int k = 0; k < D; ++k) { const float hv = h[k]; const float* w = wg + (size_t)k * NGRP; g0 += hv * w[0]; g1 += hv * w[1]; g2 += hv * w[2]; g3 += hv * w[3]; }
    g0 += bg[0]; g1 += bg[1]; g2 += bg[2]; g3 += bg[3];
    int gi = 0; float gm = g0; if (g1 > gm) { gm = g1; gi = 1; } if (g2 > gm) { gm = g2; gi = 2; } if (g3 > gm) { gm = g3; gi = 3; }
    const float gw = 1.0f / (expf(g0 - gm) + expf(g1 - gm) + expf(g2 - gm) + expf(g3 - gm));
    float e0 = 0, e1 = 0, e2 = 0, e3 = 0, e4 = 0, e5 = 0, e6 = 0, e7 = 0;
    for (int k = 0; k < D; ++k) { const float hv = h[k]; const float* w = wrt + (size_t)k * NEXP + gi * EPG;
        e0 += hv * w[0]; e1 += hv * w[1]; e2 += hv * w[2]; e3 += hv * w[3]; e4 += hv * w[4]; e5 += hv * w[5]; e6 += hv * w[6]; e7 += hv * w[7]; }
    const float* bp = brt + gi * EPG;
    e0 += bp[0]; e1 += bp[1]; e2 += bp[2]; e3 += bp[3]; e4 += bp[4]; e5 += bp[5]; e6 += bp[6]; e7 += bp[7];
    int j0 = 0; float v0 = e0;
    if (e1 > v0) { v0 = e1; j0 = 1; } if (e2 > v0) { v0 = e2; j0 = 2; } if (e3 > v0) { v0 = e3; j0 = 3; } if (e4 > v0) { v0 = e4; j0 = 4; }
    if (e5 > v0) { v0 = e5; j0 = 5; } if (e6 > v0) { v0 = e6; j0 = 6; } if (e7 > v0) { v0 = e7; j0 = 7; }
    int j1 = -1; float v1 = -3.0e38f;
    if (j0 != 0 && e0 > v1) { v1 = e0; j1 = 0; } if (j0 != 1 && e1 > v1) { v1 = e1; j1 = 1; } if (j0 != 2 && e2 > v1) { v1 = e2; j1 = 2; } if (j0 != 3 && e3 > v1) { v1 = e3; j1 = 3; }
    if (j0 != 4 && e4 > v1) { v1 = e4; j1 = 4; } if (j0 != 5 && e5 > v1) { v1 = e5; j1 = 5; } if (j0 != 6 && e6 > v1) { v1 = e6; j1 = 6; } if (j0 != 7 && e7 > v1) { v1 = e7; j1 = 7; }
    const float p1 = expf(v1 - v0), inv = 1.0f / (1.0f + p1);
    expert[t * 2] = gi * EPG + j0; expert[t * 2 + 1] = gi * EPG + j1; gate[t * 2] = gw * inv; gate[t * 2 + 1] = gw * p1 * inv;
    atomicAdd(&counts[gi * EPG + j0], 1); atomicAdd(&counts[gi * EPG + j1], 1);
}
__device__ __forceinline__ void d_moe_offsets(const int* counts, int* pad_start, int* blk_e, int* fill, const Dims& dm) {
    int acc = 0;
    for (int e = 0; e < NEXP; ++e) { pad_start[e] = acc; fill[e] = 0; const int pc = (counts[e] + 127) / 128 * 128; for (int b = acc / 128; b < (acc + pc) / 128; ++b) blk_e[b] = e; acc += pc; }
    for (int b = acc / 128; b < dm.nslots / 128; ++b) blk_e[b] = NEXP - 1;
}
__device__ __forceinline__ void d_moe_scatter(size_t i, const int* expert, const int* pad_start, int* fill, int* slot_of, int* tok_of_slot, const Dims& dm) {
    const int e = expert[i]; const int pos = atomicAdd(&fill[e], 1); const int slot = pad_start[e] + pos;
    slot_of[i] = slot; tok_of_slot[slot] = (int)(i / 2);
}
__device__ __forceinline__ void d_moe_combine(size_t i, const float* O, const int* slot_of, const float* gate, float* F, const Dims& dm) {
    const int t = (int)(i / D), d = (int)(i % D);
    F[i] = gate[t * 2] * O[(size_t)slot_of[t * 2] * D + d] + gate[t * 2 + 1] * O[(size_t)slot_of[t * 2 + 1] * D + d];
}

constexpr float QSCALE = 0.18033688011112042f;
__device__ __forceinline__ void d_rope_table(size_t i, float* ROPE) {
    const int coord = (int)(i / 16), fi = (int)(i % 16); const float ang = (float)coord * powf(10000.0f, -(float)(2 * fi) / 32.0f);
    ROPE[i] = cosf(ang); ROPE[128 * 16 + i] = sinf(ang);
}
__device__ __forceinline__ void d_inproj_act(size_t i, bf16_t* P, bf16_t* VT, const float* ROPE, const Dims& dm) {
    const size_t t = i / (IN_W / 2); const int r = (int)(i % (IN_W / 2)), c0 = (r / 16) * 32 + (r % 16), c1 = c0 + 16, fi = r % 16;
    const int b = (int)(t / dm.TPB), p = (int)(t % dm.TPB);
    bf16_t* row = P + t * IN_W; float x0 = bf2f(row[c0]), x1 = bf2f(row[c1]);
    const bool isq = c0 < OFF_U, isk = (c0 >= OFF_K && c0 < OFF_VAL);
    if (isq || isk) {
        if (p >= CTX) { const int pos = p - CTX, axis = (c0 / 32) & 1, coord = axis ? (pos % 64) : (pos / 64); const float cs = ROPE[coord * 16 + fi], sn = ROPE[128 * 16 + coord * 16 + fi];
            const float y0 = x0 * cs - x1 * sn, y1 = x1 * cs + x0 * sn; x0 = y0; x1 = y1; }
        if (isq) { x0 *= QSCALE; x1 *= QSCALE; }
    } else if ((c0 >= OFF_U && c0 < OFF_G) || (c0 >= OFF_Z && c0 < OFF_K)) { x0 = geluf_(x0); x1 = geluf_(x1); }
    else if (c0 >= OFF_G && c0 < OFF_Z) { x0 = sigmoidf_(x0); x1 = sigmoidf_(x1); }
    else if (c0 >= OFF_VAL && c0 < OFF_XR) { const int d0 = c0 - OFF_VAL, d1 = c1 - OFF_VAL;
        VT[((size_t)(b * NKV + d0 / HD) * HD + d0 % HD) * dm.TPB + p] = f2bf(x0); VT[((size_t)(b * NKV + d1 / HD) * HD + d1 % HD) * dm.TPB + p] = f2bf(x1); }
    row[c0] = f2bf(x0); row[c1] = f2bf(x1);
}
__device__ __forceinline__ void d_attn_ref(size_t i, const bf16_t* P, const bf16_t* VT, const float* sink, bf16_t* BO, const Dims& dm) {
    const int t = (int)(i / NH), h = (int)(i % NH), kv = h / (NH / NKV), b = t / dm.TPB, p = t % dm.TPB;
    float q[HD], o[HD];
    for (int d = 0; d < HD; ++d) { q[d] = bf2f(P[(size_t)t * IN_W + OFF_Q + h * HD + d]); o[d] = 0.f; }
    float m = sink[h] * 1.4426950408889634f, l = 1.0f;
    int lo = 0, hi = -1;
    if (p >= CTX) { const int pos = p - CTX; lo = pos - WIN < 0 ? 0 : pos - WIN; hi = pos + WIN > dm.S - 1 ? dm.S - 1 : pos + WIN; }
    const int nloc = hi - lo + 1 > 0 ? hi - lo + 1 : 0;
    for (int jj = 0; jj < CTX + nloc; ++jj) {
        const int kp = jj < CTX ? jj : CTX + lo + (jj - CTX); const bf16_t* kr = P + ((size_t)b * dm.TPB + kp) * IN_W + OFF_K + kv * HD;
        float s = 0.f; for (int d = 0; d < HD; ++d) s += q[d] * bf2f(kr[d]);
        if (s > m) { const float sc = exp2f(m - s); l *= sc; for (int d = 0; d < HD; ++d) o[d] *= sc; m = s; }
        const float pe = bf2f(f2bf(exp2f(s - m))); l += pe;
        for (int d = 0; d < HD; ++d) o[d] += pe * bf2f(VT[((size_t)(b * NKV + kv) * HD + d) * dm.TPB + kp]);
    }
    for (int d = 0; d < HD; ++d) BO[(size_t)t * ABR_LD + h * HD + d] = f2bf(o[d] / l);
}

__device__ __forceinline__ float softplus_neg(float lam) { const float nl = -lam; return nl > 20.f ? nl : log1pf(expf(nl)); }
__device__ __forceinline__ float one_minus_exp(float x) {
    return x > -0.125f ? -x * (1.0f + x * (0.5f + x * (0.16666667f + x * (0.041666668f + x * 0.0083333338f)))) : 1.0f - expf(x); }
__device__ __forceinline__ void d_lru_local_ref(size_t i, const bf16_t* P, const float* cw, const float* cb, const float* wr, const float* br, const float* wi, const float* bi, const float* cchp,
                                                bf16_t* HL, bf16_t* AC, float* SUMA, float* SUMH, const Dims& dm) {
    const int nch = dm.T / CHUNK, ch = (int)(i % LRU_W), q = (int)((i / LRU_W) % nch), dir = (int)(i / ((size_t)LRU_W * nch));
    const int cpb = dm.TPB / CHUNK, b = q / cpb, p0 = (q % cpb) * CHUNK, blk = ch / LRU_BW, dc = ch % LRU_BW;
    const float* wrp = wr + ((size_t)(dir * 8 + blk) * LRU_BW) * LRU_BW + dc; const float* wip = wi + ((size_t)(dir * 8 + blk) * LRU_BW) * LRU_BW + dc;
    const float cch = cchp[dir * LRU_W + ch];
    float h = 0.f, A = 1.f;
    for (int s_ = 0; s_ < CHUNK; ++s_) {
        const int p = p0 + (dir ? CHUNK - 1 - s_ : s_); float ar = 0.f, ai = 0.f;
        for (int c = 0; c < LRU_BW; ++c) { const float tv = bf2f(f2bf(conv_at(P, cw, cb, dir, b, p, blk * LRU_BW + c, dm))); ar += tv * bf2f(f2bf(wrp[(size_t)c * LRU_BW])); ai += tv * bf2f(f2bf(wip[(size_t)c * LRU_BW])); }
        const float r = sigmoidf_(ar + br[dir * LRU_W + ch]), ig = sigmoidf_(ai + bi[dir * LRU_W + ch]);
        const float la = cch * r, a = expf(la), mult = sqrtf(one_minus_exp(2.0f * la));
        const float tv = bf2f(f2bf(conv_at(P, cw, cb, dir, b, p, ch, dm)));
        h = a * h + mult * ig * tv; A *= a;
        const size_t o = ((size_t)dir * dm.T + (size_t)b * dm.TPB + p) * LRU_W + ch; HL[o] = f2bf(h); AC[o] = f2bf(A);
    }
    SUMA[((size_t)dir * nch + q) * LRU_W + ch] = A; SUMH[((size_t)dir * nch + q) * LRU_W + ch] = h;
}
__device__ __forceinline__ float lru_carry(const float* SUMA, const float* SUMH, int nch, int cpb, int dir, int b, int cq, int ch) {
    const float* sa = SUMA + ((size_t)dir * nch + (size_t)b * cpb) * LRU_W + ch; const float* sh = SUMH + ((size_t)dir * nch + (size_t)b * cpb) * LRU_W + ch; float c = 0.f;
    if (!dir) { for (int k = 0; k < cq; ++k) c = sa[(size_t)k * LRU_W] * c + sh[(size_t)k * LRU_W]; }
    else { if (cq == 0 || cq >= 2) c = sh[(size_t)1 * LRU_W];
           if (cq >= 2) { c = sa[0] * c + sh[0]; for (int k = cpb - 1; k > cq; --k) c = sa[(size_t)k * LRU_W] * c + sh[(size_t)k * LRU_W]; } }
    return c;
}
__device__ __forceinline__ void d_lru_fix_ref(size_t i, const bf16_t* P, const bf16_t* HL, const bf16_t* AC, const float* SUMA, const float* SUMH, bf16_t* RO, const Dims& dm) {
    const int t = (int)(i / LRU_W), ch = (int)(i % LRU_W), b = t / dm.TPB, p = t % dm.TPB, cq = p / CHUNK, nch = dm.T / CHUNK, cpb = dm.TPB / CHUNK;
    const float c0 = lru_carry(SUMA, SUMH, nch, cpb, 0, b, cq, ch), c1 = lru_carry(SUMA, SUMH, nch, cpb, 1, b, cq, ch);
    const size_t o0 = (size_t)t * LRU_W + ch, o1 = ((size_t)dm.T + t) * LRU_W + ch;
    RO[(size_t)t * ABR_LD + ch] = f2bf((bf2f(HL[o0]) + bf2f(AC[o0]) * c0 + bf2f(HL[o1]) + bf2f(AC[o1]) * c1) * bf2f(P[(size_t)t * IN_W + OFF_Z + ch]));
}

__device__ __forceinline__ void d_ln1_route(size_t t, const float* X0, float* X, const float* YO, const float* MODl, const float* g, const float* bb, float alpha, bf16_t* Hb,
                                            const float* wg, const float* bg, const float* wrt, const float* brt, int* cnt, int* list, int cap, int* tokinfo, float* tokgate, const Dims& dm) {
    for (int d = 0; d < D; ++d) X[t * D + d] = X0[t * D + d];
    d_ln_res(t, X, YO, MODl, 2, g, bb, alpha, dm);
    const int b = (int)(t / dm.TPB), p = (int)(t % dm.TPB), row = p < CTX ? NB : b;
    const float* m = MODl + (size_t)row * NMOD * D; const float* x = X + t * D;
    for (int d = 0; d < D; ++d) Hb[t * D + d] = f2bf(x[d] * (1.0f + m[4 * D + d]) + m[3 * D + d]);
    float g0 = 0, g1 = 0, g2 = 0, g3 = 0;
    for (int k = 0; k < D; ++k) { const float hv = x[k] * (1.0f + m[4 * D + k]) + m[3 * D + k]; const float* w = wg + (size_t)k * NGRP; g0 += hv * w[0]; g1 += hv * w[1]; g2 += hv * w[2]; g3 += hv * w[3]; }
    g0 += bg[0]; g1 += bg[1]; g2 += bg[2]; g3 += bg[3];
    int gi = 0; float gm = g0; if (g1 > gm) { gm = g1; gi = 1; } if (g2 > gm) { gm = g2; gi = 2; } if (g3 > gm) { gm = g3; gi = 3; }
    const float gw = 1.0f / (expf(g0 - gm) + expf(g1 - gm) + expf(g2 - gm) + expf(g3 - gm));
    float ev[8] = {0, 0, 0, 0, 0, 0, 0, 0};
    for (int k = 0; k < D; ++k) { const float hv = x[k] * (1.0f + m[4 * D + k]) + m[3 * D + k]; const float* w = wrt + (size_t)k * NEXP + gi * EPG; for (int j = 0; j < 8; ++j) ev[j] += hv * w[j]; }
    for (int j = 0; j < 8; ++j) ev[j] += brt[gi * EPG + j];
    int j0 = 0; for (int j = 1; j < 8; ++j) if (ev[j] > ev[j0]) j0 = j;
    int j1 = -1; for (int j = 0; j < 8; ++j) if (j != j0 && (j1 < 0 || ev[j] > ev[j1])) j1 = j;
    const float p1 = expf(ev[j1] - ev[j0]), inv = 1.0f / (1.0f + p1);
    const int e0 = gi * EPG + j0, e1 = gi * EPG + j1;
    const int pos0 = atomicAdd(&cnt[e0 * CNT_STRIDE], 1), pos1 = atomicAdd(&cnt[e1 * CNT_STRIDE], 1);
    list[(size_t)e0 * cap + pos0] = (int)t; list[(size_t)e1 * cap + pos1] = (int)t;
    tokinfo[t * 4] = e0; tokinfo[t * 4 + 1] = pos0; tokinfo[t * 4 + 2] = e1; tokinfo[t * 4 + 3] = pos1; tokgate[t * 2] = gw * inv; tokgate[t * 2 + 1] = gw * p1 * inv;
}
__device__ __forceinline__ void d_moe_tst(const int* cnt, int* tst) { int acc = 0; for (int e = 0; e < NEXP; ++e) { tst[e] = acc; acc += (cnt[e * CNT_STRIDE] + 255) / 256; } tst[NEXP] = acc; }
__device__ __forceinline__ int moe_expert_of_tile(const int* tst, int q) { int e = 0; for (int k = 1; k < NEXP; ++k) e += (tst[k] <= q) ? 1 : 0; return e; }
__device__ __forceinline__ void d_moe1_ref(size_t i, const bf16_t* Hb, const float* w1, const float* w3, const int* cnt, const int* tst, const int* list, int cap, bf16_t* HH) {
    const int j = (int)(i % DEXP); const size_t slot = i / DEXP; const int q = (int)(slot / 256), rr = (int)(slot % 256), e = moe_expert_of_tile(tst, q), r = q - tst[e];
    const int tok = (256 * r + rr < cnt[e * CNT_STRIDE]) ? list[(size_t)e * cap + 256 * r + rr] : 0;
    const float* a1 = w1 + (size_t)e * D * DEXP + j; const float* a3 = w3 + (size_t)e * D * DEXP + j; float sa = 0.f, sb = 0.f;
    for (int k = 0; k < D; ++k) { const float hv = bf2f(Hb[(size_t)tok * D + k]); sa += hv * bf2f(f2bf(a1[(size_t)k * DEXP])); sb += hv * bf2f(f2bf(a3[(size_t)k * DEXP])); }
    HH[slot * DEXP + j] = f2bf(sa / (1.0f + expf(-sa)) * sb);
}
__device__ __forceinline__ void d_moe2_ref(size_t i, const bf16_t* HH, const float* w2, const int* tst, bf16_t* O) {
    const int n = (int)(i % D); const size_t slot = i / D; const int q = (int)(slot / 256), e = moe_expert_of_tile(tst, q);
    const float* a = w2 + (size_t)e * DEXP * D + n; float acc = 0.f;
    for (int k = 0; k < DEXP; ++k) acc += bf2f(HH[slot * DEXP + k]) * bf2f(f2bf(a[(size_t)k * D]));
    O[slot * D + n] = f2bf(acc);
}
__device__ __forceinline__ void d_combine_ln2(size_t t, const float* X1, float* X, const bf16_t* O, const int* tst, const int* tokinfo, const float* tokgate, const float* MODl, const float* MODn,
                                              const float* g, const float* bb, float alpha, bf16_t* Hb, float* out, const Dims& dm) {
    const int b = (int)(t / dm.TPB), p = (int)(t % dm.TPB), row = p < CTX ? NB : b;
    const float* m = MODl + (size_t)row * NMOD * D + 5 * D; float* x = X + t * D; for (int d = 0; d < D; ++d) x[d] = X1[t * D + d];
    const size_t s0 = (size_t)256 * tst[tokinfo[t * 4]] + tokinfo[t * 4 + 1], s1 = (size_t)256 * tst[tokinfo[t * 4 + 2]] + tokinfo[t * 4 + 3];
    const float g0 = tokgate[t * 2], g1 = tokgate[t * 2 + 1];
    float s = 0.f; for (int d = 0; d < D; ++d) s += alpha * x[d] + m[d] * (g0 * bf2f(O[s0 * D + d]) + g1 * bf2f(O[s1 * D + d]));
    const float mu = s / D; float q = 0.f;
    for (int d = 0; d < D; ++d) { const float v = alpha * x[d] + m[d] * (g0 * bf2f(O[s0 * D + d]) + g1 * bf2f(O[s1 * D + d])) - mu; q += v * v; }
    const float rstd = 1.0f / sqrtf(q / D + LN_EPS);
    for (int d = 0; d < D; ++d) { const float xn = (alpha * x[d] + m[d] * (g0 * bf2f(O[s0 * D + d]) + g1 * bf2f(O[s1 * D + d])) - mu) * rstd * g[d] + bb[d]; x[d] = xn;
        if (MODn) { const float* mn = MODn + (size_t)row * NMOD * D; Hb[t * D + d] = f2bf(xn * (1.0f + mn[D + d]) + mn[d]); }
        else if (p >= CTX) out[((size_t)b * dm.S + (p - CTX)) * D + d] = xn; }
}

struct In {
    const float *x, *c, *ctx, *c_ctx, *w_mod, *b_mod, *w_in, *b_in, *sgu_ln_g, *sgu_ln_b, *w_spatial, *b_spatial, *attn_sink, *conv_w, *conv_b,
        *w_rgate, *b_rgate, *w_igate, *b_igate, *lru_lambda, *w_proj_a, *w_proj_b, *w_proj_c, *w_out, *b_out, *ln1_g, *ln1_b, *ln2_g, *ln2_b,
        *w_group, *b_group, *w_router, *b_router, *w1, *w3, *w2;
};


constexpr size_t WS_CTL = 0, CTL_BYTES = 65536;
constexpr size_t WS_YCTXFLAG = 53248;
constexpr size_t WS_CARRYFLAG = 49152;
struct Bufs {
    size_t ws_end;
    float *MOD, *X, *H, *gate, *AA, *UU, *VN, *QK, *PA, *PB, *PC, *YO, *G1, *G3, *HH, *O, *F;
    bf16_t *Hb, *P, *AO, *BO, *RO, *Y;
    bf16_t *Win_t, *Wabc_t, *Wo_t, *PS;
    int *expert, *slot_of, *tok_of_slot, *counts, *pad_start, *fill, *blk_e;
    int *cnt, *tst, *list, *tokinfo; float* tokgate; bf16_t *W13_t, *W2_t, *HHb, *Ob;
    bf16_t *Wsp_b;
    bf16_t *VT; float* ROPE;
    bf16_t *HL, *AC, *Wr_t, *Wi_t; float *SUMA, *SUMH, *CCH, *CARRY;
};
__host__ __device__ __forceinline__ size_t al256(size_t x) { return (x + 255) / 256 * 256; }
__host__ __device__ __forceinline__ Bufs make_bufs(char* ws, const Dims& dm) {
    const size_t T = dm.T, L = dm.L; Bufs b; size_t off = CTL_BYTES;
    b.MOD = (float*)(ws + off); off += al256(L * (NB + 1) * NMOD * D * 4);
    b.X = (float*)(ws + off); off += al256(T * D * 4);
    b.H = (float*)(ws + off); off += al256(T * D * 4);
    b.Hb = (bf16_t*)(ws + off); off += al256(T * D * 2);
    b.AO = (bf16_t*)(ws + off); off += al256(T * ABR_LD * 2); b.BO = b.AO + SGU_W; b.RO = b.AO + SGU_W + ATT_W;
    b.Y = (bf16_t*)(ws + off); off += al256(T * D * 2);
    b.expert = (int*)(ws + off); off += al256(T * 2 * 4);
    b.gate = (float*)(ws + off); off += al256(T * 2 * 4);
    b.slot_of = (int*)(ws + off); off += al256(T * 2 * 4);
    b.tok_of_slot = (int*)(ws + off); off += al256((size_t)dm.nslots * 4);
    b.counts = (int*)(ws + off); off += 256; b.pad_start = (int*)(ws + off); off += 256; b.fill = (int*)(ws + off); off += 256;
    b.blk_e = (int*)(ws + off); off += al256((size_t)(dm.nslots / 128) * 4);
    b.cnt = (int*)(ws + off); off += NEXP * CNT_STRIDE * 4; b.tst = (int*)(ws + off); off += 256;
    b.list = (int*)(ws + off); off += al256((size_t)NEXP * (T * 2) * 4);
    b.tokinfo = (int*)(ws + off); off += al256(T * 4 * 4);
    b.tokgate = (float*)(ws + off); off += al256(T * 2 * 4);
    b.W13_t = (bf16_t*)(ws + off); off += al256((size_t)NEXP * 2 * DEXP * D * 2);
    b.W2_t = (bf16_t*)(ws + off); off += al256((size_t)NEXP * D * DEXP * 2);
    b.CCH = (float*)(ws + off); off += al256(L * 2 * LRU_W * 4);
    b.ROPE = (float*)(ws + off); off += al256(2 * 128 * 16 * 4);
    b.Wsp_b = (bf16_t*)(ws + off); off += al256(L * 4 * CHUNK * CHUNK * 2);
    b.VT = (bf16_t*)(ws + off); off += al256(T * KV_W * 2);
    b.CARRY = (float*)(ws + off); off += al256((size_t)2 * (T / CHUNK) * LRU_W * 4);
    b.SUMA = (float*)(ws + off); off += al256((size_t)2 * (T / CHUNK) * LRU_W * 4);
    b.SUMH = (float*)(ws + off); off += al256((size_t)2 * (T / CHUNK) * LRU_W * 4);
    b.Wr_t = (bf16_t*)(ws + off); off += al256(L * 2 * 8 * LRU_BW * LRU_BW * 2);
    b.Wi_t = (bf16_t*)(ws + off); off += al256(L * 2 * 8 * LRU_BW * LRU_BW * 2);
    b.Win_t = (bf16_t*)(ws + off); off += al256(L * IN_W * D * 2);
    b.Wabc_t = (bf16_t*)(ws + off); off += al256(L * D * ABR_LD * 2);
    b.Wo_t = (bf16_t*)(ws + off); off += al256(L * D * D * 2);
    const size_t pbytes = T * IN_W * 2, mbytes = (size_t)dm.nslots * (3 * DEXP + D) * 4;
    b.P = (bf16_t*)(ws + off); off += al256(pbytes > mbytes ? pbytes : mbytes);
    char* S1 = ws + off; off += al256(T * LRU_W * 4 * 3);
    b.AA = (float*)S1; b.UU = b.AA + 2 * T * LRU_W;
    b.HL = (bf16_t*)S1; b.AC = b.HL + 2 * T * LRU_W;
    b.VN = (float*)b.Y; b.QK = (float*)(S1 + T * SGU_W * 4);
    b.PA = (float*)S1; b.PB = b.PA + T * D; b.PC = b.PB + T * D;
    b.PS = (bf16_t*)(S1 + T * D * 4);
    b.YO = b.PA;
    b.G1 = (float*)b.P; b.G3 = b.G1 + (size_t)dm.nslots * DEXP; b.HH = b.G3 + (size_t)dm.nslots * DEXP; b.O = b.HH + (size_t)dm.nslots * DEXP;
    b.F = (float*)S1;
    const size_t nsl = ((T * 2 + 255) / 256 + NEXP) * 256;
    b.ws_end = off; b.HHb = b.P; b.Ob = b.P + nsl * DEXP;
    return b;
}

struct Args { In in; Bufs B; float* out; char* ws; Dims dm; };
#ifndef CPU_SHIM
__device__ __forceinline__ int ltid() { int t = threadIdx.x; asm volatile("" : "+v"(t)); return t; }
constexpr int NWG = 256;
constexpr int RING_OFF = 0, RING_BYTES = 131072;
constexpr int MISC_OFF = RING_BYTES;
constexpr int LDS_BYTES = 147456;
typedef unsigned v4u __attribute__((ext_vector_type(4)));
typedef float f32x4 __attribute__((ext_vector_type(4)));
typedef unsigned u32x2 __attribute__((ext_vector_type(2)));
__device__ __forceinline__ unsigned pk2(float lo, float hi) { return cvt_pk_bf16(lo, hi); }
struct TileSrc { const float* W; int N, k0, n0; bf16_t* WTr; int ldt; };
__device__ __forceinline__ void tile_load(const TileSrc& t, int lane, f32x4 (&v)[8]) {
    const int r8 = lane >> 3, c4 = lane & 7;
#pragma unroll
    for (int i = 0; i < 8; ++i) v[i] = *(const f32x4*)(t.W + (size_t)(t.k0 + r8 + 8 * i) * t.N + t.n0 + 4 * c4);
}
__device__ __forceinline__ void tile_store(const TileSrc& t, int lane, const f32x4 (&v)[8], LAS float* scr) {
    const int r8 = lane >> 3, c4 = lane & 7;
#pragma unroll
    for (int i = 0; i < 8; ++i) { LAS float* sp = scr + (r8 + 8 * i) * 33 + 4 * c4; sp[0] = v[i].x; sp[1] = v[i].y; sp[2] = v[i].z; sp[3] = v[i].w; }
    asm volatile("s_waitcnt lgkmcnt(0)" ::: "memory");
    const int c = lane & 7;
#pragma unroll
    for (int j = 0; j < 4; ++j) { const int n = (lane >> 3) + 8 * j; const LAS float* sp = scr + (8 * c) * 33 + n;
        v4u o; o.x = pk2(sp[0 * 33], sp[1 * 33]); o.y = pk2(sp[2 * 33], sp[3 * 33]); o.z = pk2(sp[4 * 33], sp[5 * 33]); o.w = pk2(sp[6 * 33], sp[7 * 33]);
        *(v4u*)(t.WTr + (size_t)n * t.ldt + t.k0 + 8 * c) = o; }
    asm volatile("s_waitcnt lgkmcnt(0)" ::: "memory");
}
__device__ __forceinline__ void p0_transpose_tile(const float* W, int K, int N, int k0, int n0, bf16_t* WTr, int ldt, LAS float* scr, int lane) {
    (void)K; const TileSrc t{W, N, k0, n0, WTr, ldt}; f32x4 v[8]; tile_load(t, lane, v); tile_store(t, lane, v, scr);
}
__device__ __forceinline__ void p0_transpose_item(const float* W, int K, int N, bf16_t* WT, LAS float* scr, int item, int lane) {
    const int nblk = N / 32, kb = item / nblk, nb = item % nblk;
    p0_transpose_tile(W, K, N, 64 * kb, 32 * nb, WT + (size_t)(32 * nb) * K, K, scr, lane);
}
__device__ __forceinline__ void p0_transpose_item_ld(const float* W, int K, int N, bf16_t* WT, int ldt, LAS float* scr, int item, int lane) {
    const int nblk = N / 32, kb = item / nblk, nb = item % nblk;
    p0_transpose_tile(W, K, N, 64 * kb, 32 * nb, WT + (size_t)(32 * nb) * ldt, ldt, scr, lane);
}
__device__ __forceinline__ TileSrc moe_weight_tile(const float* w1, const float* w3, const float* w2, bf16_t* W13_t, bf16_t* W2_t, int item) {
    const int which = item / (NEXP * 256), r = item % (NEXP * 256), e = r / 256, ti = r % 256;
    if (which < 2) { const int kb = ti / (DEXP / 32), nb = ti % (DEXP / 32), n0 = 32 * nb;
        return TileSrc{(which ? w3 : w1) + (size_t)e * D * DEXP, DEXP, 64 * kb, n0, W13_t + ((size_t)e * 1024 + (n0 / 128) * 256 + which * 128 + (n0 % 128)) * D, D}; }
    const int kb = ti / (D / 32), nb = ti % (D / 32), n0 = 32 * nb;
    return TileSrc{w2 + (size_t)e * DEXP * D, D, 64 * kb, n0, W2_t + ((size_t)e * 1024 + n0) * DEXP, DEXP};
}
#endif

#ifndef CPU_SHIM
__device__ __forceinline__ float wave_sum(float v, int lane) {
#pragma unroll
    for (int o = 1; o < 64; o <<= 1) v += __int_as_float(__builtin_amdgcn_ds_bpermute((lane ^ o) << 2, __float_as_int(v)));
    return v;
}
__device__ __forceinline__ float hsum4(f32x4 v) { return (v.x + v.y) + (v.z + v.w); }
__device__ __forceinline__ u32x2 pk4(f32x4 v) { u32x2 r; r.x = pk2(v.x, v.y); r.y = pk2(v.z, v.w); return r; }
__device__ __forceinline__ f32x4 unpk4(u32x2 r) { f32x4 v; v.x = __uint_as_float(r.x << 16); v.y = __uint_as_float(r.x & 0xffff0000u); v.z = __uint_as_float(r.y << 16); v.w = __uint_as_float(r.y & 0xffff0000u); return v; }
__device__ __forceinline__ void ln1_route_wave(int t, int lane, const float* X, float* X1, const float* YO, const float* MODl, const float* g1, const float* b1, float alpha, bf16_t* Hb,
                                               const float* wg, const float* bg, const LAS float* wrl, const float* brt, LAS int* lcnt, LAS int* rec, float* tokgate, const Dims& dm) {
    const int b = t / dm.TPB, p = t % dm.TPB, row = p < CTX ? NB : b;
    const float* m = MODl + (size_t)row * NMOD * D; const float* xr = X + (size_t)t * D; float* xw = X1 + (size_t)t * D; const float* yr = YO + (size_t)t * D;
    f32x4 v[4]; float s = 0.f;
#pragma unroll
    for (int j = 0; j < 4; ++j) { const int c = 256 * j + 4 * lane; v[j] = alpha * *(const f32x4*)(xr + c) + *(const f32x4*)(m + 2 * D + c) * *(const f32x4*)(yr + c); s += hsum4(v[j]); }
    const float mean = wave_sum(s, lane) * (1.0f / D); float q = 0.f;
#pragma unroll
    for (int j = 0; j < 4; ++j) { v[j] = v[j] - mean; q += hsum4(v[j] * v[j]); }
    const float rstd = 1.0f / sqrtf(wave_sum(q, lane) * (1.0f / D) + LN_EPS);
    float gl[4] = {0.f, 0.f, 0.f, 0.f};
#pragma unroll
    for (int j = 0; j < 4; ++j) { const int c = 256 * j + 4 * lane;
        const f32x4 xn = v[j] * rstd * *(const f32x4*)(g1 + c) + *(const f32x4*)(b1 + c); *(f32x4*)(xw + c) = xn;
        v[j] = xn * (1.0f + *(const f32x4*)(m + 4 * D + c)) + *(const f32x4*)(m + 3 * D + c);
        *(u32x2*)(Hb + (size_t)t * D + c) = pk4(v[j]);
#pragma unroll
        for (int e = 0; e < 4; ++e) { const f32x4 w = *(const f32x4*)(wg + (size_t)(c + e) * NGRP); gl[0] += v[j][e] * w.x; gl[1] += v[j][e] * w.y; gl[2] += v[j][e] * w.z; gl[3] += v[j][e] * w.w; } }
#pragma unroll
    for (int i = 0; i < 4; ++i) gl[i] = wave_sum(gl[i], lane) + bg[i];
    int gi = 0; float gm = gl[0]; if (gl[1] > gm) { gm = gl[1]; gi = 1; } if (gl[2] > gm) { gm = gl[2]; gi = 2; } if (gl[3] > gm) { gm = gl[3]; gi = 3; }
    const float gw = 1.0f / (expf(gl[0] - gm) + expf(gl[1] - gm) + expf(gl[2] - gm) + expf(gl[3] - gm));
    float ev[8] = {0.f, 0.f, 0.f, 0.f, 0.f, 0.f, 0.f, 0.f};
#pragma unroll
    for (int j = 0; j < 4; ++j) { const int c = 256 * j + 4 * lane;
#pragma unroll
        for (int e = 0; e < 4; ++e) { const LAS float* wp = wrl + ((gi * D + 256 * j + 64 * e + lane) * 8); const f32x4 w0 = *(const LAS f32x4*)wp, w1 = *(const LAS f32x4*)(wp + 4); const float hv = v[j][e]; (void)c;
            ev[0] += hv * w0.x; ev[1] += hv * w0.y; ev[2] += hv * w0.z; ev[3] += hv * w0.w; ev[4] += hv * w1.x; ev[5] += hv * w1.y; ev[6] += hv * w1.z; ev[7] += hv * w1.w; } }
#pragma unroll
    for (int i = 0; i < 8; ++i) ev[i] = wave_sum(ev[i], lane) + brt[gi * EPG + i];
    int j0 = 0; float v0 = ev[0];
#pragma unroll
    for (int i = 1; i < 8; ++i) if (ev[i] > v0) { v0 = ev[i]; j0 = i; }
    int j1 = -1; float v1 = -3.0e38f;
#pragma unroll
    for (int i = 0; i < 8; ++i) if (i != j0 && ev[i] > v1) { v1 = ev[i]; j1 = i; }
    if (lane == 0) {
        const float p1 = expf(v1 - v0), inv = 1.0f / (1.0f + p1); const int e0 = gi * EPG + j0, e1 = gi * EPG + j1;
        const int lp0 = __hip_atomic_fetch_add(lcnt + e0, 1, __ATOMIC_RELAXED, __HIP_MEMORY_SCOPE_WORKGROUP), lp1 = __hip_atomic_fetch_add(lcnt + e1, 1, __ATOMIC_RELAXED, __HIP_MEMORY_SCOPE_WORKGROUP);
        rec[0] = t; rec[1] = e0; rec[2] = lp0; rec[3] = e1; rec[4] = lp1;
        *(float2*)(tokgate + (size_t)t * 2) = make_float2(gw * inv, gw * p1 * inv);
    }
}
__device__ __forceinline__ void route_flush(int tl, int nrec_per_wave, LAS int* lcnt, LAS int* lbase, LAS int* recs, int* cnt, int* list, int cap, int* tokinfo) {
    __syncthreads();
    if (tl < NEXP) { const int n = lcnt[tl]; lbase[tl] = n ? atomicAdd(&cnt[tl * CNT_STRIDE], n) : 0; }
    __syncthreads();
    if (tl < 8 * nrec_per_wave) { const LAS int* r = recs + 8 * tl; const int t = r[0];
        if (t >= 0) { const int e0 = r[1], p0 = lbase[e0] + r[2], e1 = r[3], p1 = lbase[e1] + r[4];
            list[(size_t)e0 * cap + p0] = t; list[(size_t)e1 * cap + p1] = t; *(int4*)(tokinfo + (size_t)t * 4) = make_int4(e0, p0, e1, p1); } }
}
__device__ __forceinline__ void combine_ln2_wave(int t, int lane, const float* X1, float* X, const bf16_t* O, const LAS int* tst, const int* tokinfo, const float* tokgate, const float* MODl, const float* MODn,
                                                 const float* g2, const float* b2, float alpha, bf16_t* Hb, float* out, const Dims& dm) {
    const int b = t / dm.TPB, p = t % dm.TPB, row = p < CTX ? NB : b;
    const float* m = MODl + (size_t)row * NMOD * D + 5 * D; const float* xr = X1 + (size_t)t * D; float* xw = X + (size_t)t * D;
    const int4 ti = *(const int4*)(tokinfo + (size_t)t * 4); const float2 tg = *(const float2*)(tokgate + (size_t)t * 2);
    const bf16_t* o0 = O + ((size_t)256 * tst[ti.x] + ti.y) * D; const bf16_t* o1 = O + ((size_t)256 * tst[ti.z] + ti.w) * D;
    f32x4 v[4]; float s = 0.f;
#pragma unroll
    for (int j = 0; j < 4; ++j) { const int c = 256 * j + 4 * lane; const f32x4 f = tg.x * unpk4(*(const u32x2*)(o0 + c)) + tg.y * unpk4(*(const u32x2*)(o1 + c));
        v[j] = alpha * *(const f32x4*)(xr + c) + *(const f32x4*)(m + c) * f; s += hsum4(v[j]); }
    const float mean = wave_sum(s, lane) * (1.0f / D); float q = 0.f;
#pragma unroll
    for (int j = 0; j < 4; ++j) { v[j] = v[j] - mean; q += hsum4(v[j] * v[j]); }
    const float rstd = 1.0f / sqrtf(wave_sum(q, lane) * (1.0f / D) + LN_EPS);
#pragma unroll
    for (int j = 0; j < 4; ++j) { const int c = 256 * j + 4 * lane;
        const f32x4 xn = v[j] * rstd * *(const f32x4*)(g2 + c) + *(const f32x4*)(b2 + c); *(f32x4*)(xw + c) = xn;
        if (MODn) { const float* mn = MODn + (size_t)row * NMOD * D; *(u32x2*)(Hb + (size_t)t * D + c) = pk4(xn * (1.0f + *(const f32x4*)(mn + D + c)) + *(const f32x4*)(mn + c)); }
        else if (p >= CTX) *(f32x4*)(out + ((size_t)b * dm.S + (p - CTX)) * D + c) = xn; }
}
typedef short bf16x8_t __attribute__((ext_vector_type(8)));
__device__ __forceinline__ float bperm(int src_lane, float v) { return __int_as_float(__builtin_amdgcn_ds_bpermute(src_lane << 2, __float_as_int(v))); }
__device__ __forceinline__ float fast_sigmoid(float x) { return __builtin_amdgcn_rcpf(1.0f + __expf(-x)); }
__device__ __forceinline__ float gelu_fast(float x) { return x * fast_sigmoid(1.5957691216057308f * (x + 0.044715f * x * x * x)); }
constexpr int LRU_PITCH = 272;
constexpr int LRU_AT = 0, LRU_OH = 34816, LRU_OA = 69632;
template <int DIR>
__device__ __forceinline__ void lru_local_unit(int q, int blk, int tl, LAS unsigned char* lds, const bf16_t* P, const float* cw, const float* cb, const bf16_t* Wr_t, const float* br,
                                               const bf16_t* Wi_t, const float* bi, const float* cchp, bf16_t* HL, bf16_t* AC, float* SUMA, float* SUMH) {
    constexpr int CPB = Dims::TPB / CHUNK, NCH = Dims::T / CHUNK;
    const int b = q / CPB, cq = q % CPB, p0 = cq * CHUNK, seg_lo = cq < 2 ? 0 : CTX, seg_hi = cq < 2 ? CTX : Dims::TPB, ch0 = blk * LRU_BW;
    const int lane = tl & 63, w = tl >> 6, fr = lane & 15, fq = lane >> 4;
    const size_t tok0 = (size_t)b * Dims::TPB + p0;
    {
        const int cg = tl & 15, tg = tl >> 4, pb = p0 + 4 * tg - (DIR ? 0 : 3);
        float x[7][8];
#pragma unroll
        for (int i = 0; i < 7; ++i) { const int p = pb + i; v4u raw = {0u, 0u, 0u, 0u};
            if (p >= seg_lo && p < seg_hi) raw = *(const v4u*)(P + ((size_t)b * Dims::TPB + p) * IN_W + OFF_XR + ch0 + 8 * cg);
#pragma unroll
            for (int e = 0; e < 4; ++e) { x[i][2 * e] = __uint_as_float(raw[e] << 16); x[i][2 * e + 1] = __uint_as_float(raw[e] & 0xffff0000u); } }
        float wv[4][8], o[8];
#pragma unroll
        for (int j = 0; j < 4; ++j) { const float* wp = cw + (size_t)(DIR * 4 + j) * LRU_W + ch0 + 8 * cg; const f32x4 w0 = *(const f32x4*)wp, w1 = *(const f32x4*)(wp + 4);
            wv[j][0] = w0.x; wv[j][1] = w0.y; wv[j][2] = w0.z; wv[j][3] = w0.w; wv[j][4] = w1.x; wv[j][5] = w1.y; wv[j][6] = w1.z; wv[j][7] = w1.w; }
        const float* cbp = cb + DIR * LRU_W + ch0 + 8 * cg; const f32x4 c0 = *(const f32x4*)cbp, c1 = *(const f32x4*)(cbp + 4);
#pragma unroll
        for (int k = 0; k < 4; ++k) {
            o[0] = c0.x; o[1] = c0.y; o[2] = c0.z; o[3] = c0.w; o[4] = c1.x; o[5] = c1.y; o[6] = c1.z; o[7] = c1.w;
#pragma unroll
            for (int j = 0; j < 4; ++j)
#pragma unroll
                for (int e = 0; e < 8; ++e) o[e] += wv[j][e] * x[k + j][e];
            v4u pk; pk.x = pk2(o[0], o[1]); pk.y = pk2(o[2], o[3]); pk.z = pk2(o[4], o[5]); pk.w = pk2(o[6], o[7]);
            *(LAS v4u*)(lds + LRU_AT + (4 * tg + k) * LRU_PITCH + cg * 16) = pk; }
    }
    __syncthreads();
    bf16x8_t wrf[4], wif[4];
    { const size_t wo = ((size_t)(DIR * 8 + blk) * LRU_BW + 16 * w + fr) * LRU_BW + 8 * fq;
#pragma unroll
      for (int ks = 0; ks < 4; ++ks) { wrf[ks] = *(const bf16x8_t*)(Wr_t + wo + 32 * ks); wif[ks] = *(const bf16x8_t*)(Wi_t + wo + 32 * ks); } }
    f32x4 ar[8], ai[8];
#pragma unroll
    for (int m = 0; m < 8; ++m) { ar[m] = (f32x4){0.f, 0.f, 0.f, 0.f}; ai[m] = (f32x4){0.f, 0.f, 0.f, 0.f}; }
#pragma unroll
    for (int m = 0; m < 8; ++m)
#pragma unroll
        for (int ks = 0; ks < 4; ++ks) { const bf16x8_t a = *(const LAS bf16x8_t*)(lds + LRU_AT + (16 * m + fr) * LRU_PITCH + (32 * ks + 8 * fq) * 2);
            ar[m] = __builtin_amdgcn_mfma_f32_16x16x32_bf16(a, wrf[ks], ar[m], 0, 0, 0); ai[m] = __builtin_amdgcn_mfma_f32_16x16x32_bf16(a, wif[ks], ai[m], 0, 0, 0); }
    const int ch = ch0 + 16 * w + fr;
    const float cch = cchp[DIR * LRU_W + ch], brr = br[DIR * LRU_W + ch], bii = bi[DIR * LRU_W + ch];
#pragma unroll
    for (int m = 0; m < 8; ++m)
#pragma unroll
        for (int j = 0; j < 4; ++j) { const float tv = bf2f(*(const LAS bf16_t*)(lds + LRU_AT + (16 * m + 4 * fq + j) * LRU_PITCH + (16 * w + fr) * 2));
            const float r = fast_sigmoid(ar[m][j] + brr), ig = fast_sigmoid(ai[m][j] + bii), la = cch * r, xx = 2.0f * la;
            const float a = __expf(la); float omp = -xx * (1.0f + xx * (0.5f + xx * (0.16666667f + xx * (0.041666668f + xx * 0.0083333338f)))), omd = 1.0f - a * a;
            asm volatile("" : "+v"(omp), "+v"(omd));
            const float om = xx > -0.125f ? omp : omd;
            ar[m][j] = a; ai[m][j] = __builtin_amdgcn_sqrtf(om) * ig * tv; }
    const int rank = DIR ? 3 - fq : fq, src1 = DIR ? lane + 16 : lane - 16, src2 = DIR ? lane + 32 : lane - 32, srcT = DIR ? fr : fr + 48;
    float Ac = 1.f, Hc = 0.f;
#pragma unroll
    for (int mm = 0; mm < 8; ++mm) { constexpr int dummy = 0; (void)dummy; const int m = DIR ? 7 - mm : mm;
        float Al[4], Hl[4], A = 1.f, H = 0.f;
#pragma unroll
        for (int jj = 0; jj < 4; ++jj) { const int j = DIR ? 3 - jj : jj; H = ar[m][j] * H + ai[m][j]; A *= ar[m][j]; Al[j] = A; Hl[j] = H; }
        float Ai = A, Hi = H, Ap, Hp;
        Ap = bperm(src1, Ai); Hp = bperm(src1, Hi); if (rank >= 1) { Hi = Ai * Hp + Hi; Ai = Ap * Ai; }
        Ap = bperm(src2, Ai); Hp = bperm(src2, Hi); if (rank >= 2) { Hi = Ai * Hp + Hi; Ai = Ap * Ai; }
        float Ae = bperm(src1, Ai), He = bperm(src1, Hi); if (rank == 0) { Ae = 1.f; He = 0.f; }
        const float Ain = Ac * Ae, Hin = Ae * Hc + He;
        const float Am = bperm(srcT, Ai), Hm = bperm(srcT, Hi);
#pragma unroll
        for (int j = 0; j < 4; ++j) { const int off = (16 * m + 4 * fq + j) * LRU_PITCH + (16 * w + fr) * 2;
            *(LAS bf16_t*)(lds + LRU_OH + off) = f2bf(Al[j] * Hin + Hl[j]); *(LAS bf16_t*)(lds + LRU_OA + off) = f2bf(Ain * Al[j]); }
        Hc = Am * Hc + Hm; Ac = Ac * Am; }
    if (fq == 0) { SUMA[((size_t)DIR * NCH + q) * LRU_W + ch] = Ac; SUMH[((size_t)DIR * NCH + q) * LRU_W + ch] = Hc; }
    __syncthreads();
    {
        const int cg = tl & 15, tg = tl >> 4;
#pragma unroll
        for (int k = 0; k < 4; ++k) { const int row = 4 * tg + k; const size_t o = ((size_t)DIR * Dims::T + tok0 + row) * LRU_W + ch0 + 8 * cg;
            *(v4u*)(HL + o) = *(const LAS v4u*)(lds + LRU_OH + row * LRU_PITCH + cg * 16); *(v4u*)(AC + o) = *(const LAS v4u*)(lds + LRU_OA + row * LRU_PITCH + cg * 16); }
    }
    __syncthreads();
}
__device__ __forceinline__ void lru_carry_unit(int u, int tl, const float* SUMA, const float* SUMH, float* CARRY) {
    constexpr int CPB = Dims::TPB / CHUNK, NCH = Dims::T / CHUNK; constexpr int CB = 22; static_assert(CPB % CB == 0, "carry scan batches 22 chunks");
    const int b = u >> 2, dir = (u >> 1) & 1, ch = (u & 1) * 512 + tl; const size_t base = ((size_t)dir * NCH + (size_t)b * CPB) * LRU_W + ch;
    float c = 0.f;
    for (int i0 = 0; i0 < CPB; i0 += CB) { float a[CB], h[CB]; int kk[CB];
#pragma unroll
        for (int j = 0; j < CB; ++j) { const int i = i0 + j; kk[j] = dir ? (i == 0 ? 1 : (i == 1 ? 0 : CPB + 1 - i)) : i; a[j] = SUMA[base + (size_t)kk[j] * LRU_W]; h[j] = SUMH[base + (size_t)kk[j] * LRU_W]; }
#pragma unroll
        for (int j = 0; j < CB; ++j) { __hip_atomic_store(CARRY + base + (size_t)kk[j] * LRU_W, c, __ATOMIC_RELAXED, __HIP_MEMORY_SCOPE_AGENT); c = a[j] * c + h[j]; } }
}
__device__ __forceinline__ void lru_fix_rows(int t0, int nrows, int lane, const bf16_t* P, const bf16_t* HL, const bf16_t* AC, const float* CARRY, bf16_t* RO) {
    constexpr int NCH = Dims::T / CHUNK; const int ch0 = 16 * lane;
    float cf[16], cb[16]; int qc = -1;
    for (int r0 = 0; r0 < nrows; r0 += 3) {
        v4u h0[3][2], a0[3][2], h1[3][2], a1[3][2], zz[3][2];
#pragma unroll
        for (int i = 0; i < 3; ++i) { const int t = t0 + (r0 + i < nrows ? r0 + i : nrows - 1); const size_t o0 = (size_t)t * LRU_W + ch0, o1 = o0 + (size_t)Dims::T * LRU_W;
#pragma unroll
            for (int hq = 0; hq < 2; ++hq) { h0[i][hq] = *(const v4u*)(HL + o0 + 8 * hq); a0[i][hq] = *(const v4u*)(AC + o0 + 8 * hq); h1[i][hq] = *(const v4u*)(HL + o1 + 8 * hq); a1[i][hq] = *(const v4u*)(AC + o1 + 8 * hq);
                zz[i][hq] = *(const v4u*)(P + (size_t)t * IN_W + OFF_Z + ch0 + 8 * hq); } }
        __builtin_amdgcn_sched_barrier(0);
#pragma unroll
        for (int i = 0; i < 3; ++i) { if (r0 + i >= nrows) break; const int t = t0 + r0 + i, q = t >> 7;
            if (q != qc) { qc = q; const float* cfp = CARRY + (size_t)q * LRU_W + ch0; const float* cbp = cfp + (size_t)NCH * LRU_W;
#pragma unroll
                for (int k = 0; k < 4; ++k) { const f32x4 a = *(const f32x4*)(cfp + 4 * k), b = *(const f32x4*)(cbp + 4 * k);
                    cf[4 * k] = a.x; cf[4 * k + 1] = a.y; cf[4 * k + 2] = a.z; cf[4 * k + 3] = a.w; cb[4 * k] = b.x; cb[4 * k + 1] = b.y; cb[4 * k + 2] = b.z; cb[4 * k + 3] = b.w; } }
#pragma unroll
            for (int hq = 0; hq < 2; ++hq) { v4u o;
#pragma unroll
                for (int e = 0; e < 4; ++e) {
                    const float lo = (__uint_as_float(h0[i][hq][e] << 16) + __uint_as_float(a0[i][hq][e] << 16) * cf[8 * hq + 2 * e] + __uint_as_float(h1[i][hq][e] << 16) + __uint_as_float(a1[i][hq][e] << 16) * cb[8 * hq + 2 * e]) * __uint_as_float(zz[i][hq][e] << 16);
                    const float hi = (__uint_as_float(h0[i][hq][e] & 0xffff0000u) + __uint_as_float(a0[i][hq][e] & 0xffff0000u) * cf[8 * hq + 2 * e + 1] + __uint_as_float(h1[i][hq][e] & 0xffff0000u) + __uint_as_float(a1[i][hq][e] & 0xffff0000u) * cb[8 * hq + 2 * e + 1])
                                     * __uint_as_float(zz[i][hq][e] & 0xffff0000u);
                    o[e] = pk2(lo, hi); }
                *(v4u*)(RO + (size_t)t * ABR_LD + ch0 + 8 * hq) = o; } }
        __builtin_amdgcn_sched_barrier(0); }
}
struct EpiInProj {
    static constexpr bool PERM = true, AFTER_DRAIN = false, LDS_AUX = true;
    bf16_t* P; const float* bias; bf16_t* VT; const float* ROPE; LAS unsigned char* aux;
    __device__ __forceinline__ void aux_dma(const pg8::Unit& u, int par, int lane) const {
        __builtin_amdgcn_global_load_lds((const unsigned*)(bias + u.pn * 256 + lane * 4), (LAS unsigned*)(aux + par * 1024), 16, 0, 0);
        const int pr = u.pm % (Dims::TPB / 256), cb = pr ? 4 * (pr - 1) : 0;
        __builtin_amdgcn_global_load_lds((const unsigned*)(ROPE + ((lane & 16) ? 2048 : 0) + cb * 16 + (lane & 15) * 4), (LAS unsigned*)(aux + 2048 + par * 1024), 16, 0, 0);
    }
    __device__ __forceinline__ void operator()(const pg8::f32x4 (&acc)[2][2][4][2], const pg8::Unit& u, int wr, int wc, int fr, int fq, int par) const {
        const int lane = fq * 16 + fr, row0 = u.pm * 256 + wr * 64 + fr, bidx = u.pm / (Dims::TPB / 256); const bool ctxu = (u.pm % (Dims::TPB / 256)) == 0;
        const LAS float* bl = (const LAS float*)(aux + par * 1024); const LAS float* rr = (const LAS float*)(aux + 2048 + par * 1024); const LAS float* ct = (const LAS float*)(aux + 4096);
#pragma unroll
        for (int bj = 0; bj < 2; ++bj) {
            const int cbase = u.pn * 256 + bj * 128, cu = bj * 128 + wc * 32 + 8 * fq, col0 = u.pn * 256 + cu;
            const int mode = cbase < OFF_U ? 3 : cbase < OFF_G ? 1 : cbase < OFF_Z ? 0 : cbase < OFF_K ? 1 : cbase == OFF_K ? 3 : cbase == OFF_VAL ? 4 : 0;
            const f32x4 bv0 = *(const LAS f32x4*)(bl + cu), bv1 = *(const LAS f32x4*)(bl + cu + 4);
#pragma unroll
            for (int ai = 0; ai < 2; ++ai)
#pragma unroll
                for (int m = 0; m < 4; ++m) { const int row = row0 + ai * 128 + m * 16;
                    const f32x4 a0 = acc[ai][bj][m][0] + bv0, a1 = acc[ai][bj][m][1] + bv1;
                    float v[8] = {a0.x, a0.y, a0.z, a0.w, a1.x, a1.y, a1.z, a1.w};
                    if (mode == 1) {
#pragma unroll
                        for (int e = 0; e < 8; ++e) v[e] = gelu_fast(v[e]);
                    } else if (mode == 2) {
#pragma unroll
                        for (int e = 0; e < 8; ++e) v[e] = fast_sigmoid(v[e]);
                    } else if (mode == 3) {
                        if (!ctxu) {
                            const LAS float* cp = (wc & 1) ? ct + (16 * m + fr) * 16 + 8 * (fq & 1) : rr + (wr + 2 * ai) * 16 + 8 * (fq & 1); const int so = (wc & 1) ? 1024 : 64;
                            const f32x4 c0 = *(const LAS f32x4*)cp, c1 = *(const LAS f32x4*)(cp + 4), s0 = *(const LAS f32x4*)(cp + so), s1 = *(const LAS f32x4*)(cp + so + 4);
                            const float cs[8] = {c0.x, c0.y, c0.z, c0.w, c1.x, c1.y, c1.z, c1.w}, sn[8] = {s0.x, s0.y, s0.z, s0.w, s1.x, s1.y, s1.z, s1.w};
#pragma unroll
                            for (int e = 0; e < 8; ++e) { const float vp = bperm(lane ^ 32, v[e]); v[e] = v[e] * cs[e] + (fq < 2 ? -vp : vp) * sn[e]; } }
                        if (cbase < OFF_U) {
#pragma unroll
                            for (int e = 0; e < 8; ++e) v[e] *= QSCALE; }
                    } else if (mode == 4) { const int p = row - bidx * Dims::TPB; bf16_t* vt = VT + ((size_t)(bidx * NKV + (wc >> 1)) * HD + (wc & 1) * 32 + 8 * fq) * Dims::TPB + p;
#pragma unroll
                        for (int e = 0; e < 8; ++e) vt[(size_t)e * Dims::TPB] = f2bf(v[e]); }
                    pg8::u32x4 w4; w4.x = pg8::cvt_pk_bf16(v[0], v[1]); w4.y = pg8::cvt_pk_bf16(v[2], v[3]); w4.z = pg8::cvt_pk_bf16(v[4], v[5]); w4.w = pg8::cvt_pk_bf16(v[6], v[7]);
                    *(pg8::u32x4*)(P + (size_t)row * IN_W + col0) = w4; }
        }
    }
};
constexpr int ATT_KP = 144, ATT_VP = 528, ATT_K = 0, ATT_V = 256 * ATT_KP;
__device__ __forceinline__ void attn_unit(int u, int tl, LAS unsigned char* lds, const bf16_t* P, const bf16_t* VT, const float* sink, bf16_t* BO) {
    constexpr int CPB = Dims::TPB / CHUNK;
    int b, qb, kv;
    if (u < 2 * NB * (CPB - 2)) { kv = u & 1; const int jq = (u >> 1) % (CPB - 2); b = (u >> 1) / (CPB - 2); qb = jq + 2; } else { const int v_ = u - 2 * NB * (CPB - 2); kv = v_ & 1; qb = (v_ >> 1) & 1; b = v_ >> 2; }
    const int j = qb - 2;
    const int lane = tl & 63, w = tl >> 6, fr = lane & 15, fq = lane >> 4, hf = w & 1, h = kv * 4 + (w >> 1);
    const size_t trow0 = (size_t)b * Dims::TPB + (size_t)128 * qb;
    bf16x8_t qf[4][2];
#pragma unroll
    for (int nt = 0; nt < 4; ++nt)
#pragma unroll
        for (int ks = 0; ks < 2; ++ks) qf[nt][ks] = *(const bf16x8_t*)(P + (trow0 + 64 * hf + 16 * nt + fr) * IN_W + OFF_Q + h * HD + 32 * ks + 8 * fq);
    f32x4 o[4][4]; float mu[4], lp[4];
    const float sink2 = sink[h] * 1.4426950408889634f;
#pragma unroll
    for (int nt = 0; nt < 4; ++nt) { mu[nt] = sink2; lp[nt] = fq == 0 ? 1.0f : 0.0f;
#pragma unroll
        for (int dt = 0; dt < 4; ++dt) o[dt][nt] = (f32x4){0.f, 0.f, 0.f, 0.f}; }
    const int nstage = j < 0 ? 1 : (j == CPB - 3 ? 2 : 3);
    for (int st = 0; st < nstage; ++st) {
        const int kp0 = st == 0 ? 0 : (st == 1 ? 128 * qb - 128 : 128 * qb + 128), nk = st == 2 ? 128 : 256;
        __syncthreads();
        { const int row = tl >> 1, half = tl & 1;
          const bf16_t* src = P + ((size_t)b * Dims::TPB + kp0 + (row < nk ? row : 0)) * IN_W + OFF_K + kv * HD + half * 32;
          const int d = tl >> 3, seg = tl & 7; const bf16_t* vs = VT + ((size_t)(b * NKV + kv) * HD + d) * Dims::TPB + kp0;
          v4u kr[4], vr[4];
#pragma unroll
          for (int i = 0; i < 4; ++i) { kr[i] = *(const v4u*)(src + 8 * i); const int col = (seg + 8 * i) * 8; vr[i] = *(const v4u*)(vs + (col < nk ? col : 0)); }
          __builtin_amdgcn_sched_barrier(0);
          if (row < nk) {
#pragma unroll
              for (int i = 0; i < 4; ++i) *(LAS v4u*)(lds + ATT_K + row * ATT_KP + half * 64 + 16 * i) = kr[i]; }
#pragma unroll
          for (int i = 0; i < 4; ++i) { const int col = (seg + 8 * i) * 8; if (col < nk) *(LAS v4u*)(lds + ATT_V + d * ATT_VP + col * 2) = vr[i]; } }
        __syncthreads();
        const int hfu = __builtin_amdgcn_readfirstlane(hf);
        for (int kb = 0; kb < nk / 32; ++kb) {
            if (st == 1 && (32 * kb + 31 < 64 * hfu || (j == 0 && kb < 4))) continue;
            if (st == 2 && 32 * kb > 64 * hfu + 63) continue;
            f32x4 sc[2][4];
#pragma unroll
            for (int kt = 0; kt < 2; ++kt) { const bf16x8_t k0 = *(const LAS bf16x8_t*)(lds + ATT_K + (kb * 32 + 16 * kt + fr) * ATT_KP + 16 * fq), k1 = *(const LAS bf16x8_t*)(lds + ATT_K + (kb * 32 + 16 * kt + fr) * ATT_KP + 64 + 16 * fq);
#pragma unroll
                for (int nt = 0; nt < 4; ++nt) { sc[kt][nt] = __builtin_amdgcn_mfma_f32_16x16x32_bf16(k0, qf[nt][0], (f32x4){0.f, 0.f, 0.f, 0.f}, 0, 0, 0);
                    sc[kt][nt] = __builtin_amdgcn_mfma_f32_16x16x32_bf16(k1, qf[nt][1], sc[kt][nt], 0, 0, 0); } }
            if (st > 0) { const int dq = kb * 32 + 4 * fq - 64 * hf - fr, kq = kb * 32 + 4 * fq + (j > 0 ? 128 : 0);
                if (st == 1) {
#pragma unroll
                    for (int kt = 0; kt < 2; ++kt)
#pragma unroll
                        for (int nt = 0; nt < 4; ++nt)
#pragma unroll
                            for (int r = 0; r < 4; ++r) { const int c = 16 * kt + r - 16 * nt; const bool ok = (dq >= -c) & (kq >= 128 - 16 * kt - r); sc[kt][nt][r] = ok ? sc[kt][nt][r] : -1.0e30f; }
                } else {
#pragma unroll
                    for (int kt = 0; kt < 2; ++kt)
#pragma unroll
                        for (int nt = 0; nt < 4; ++nt)
#pragma unroll
                            for (int r = 0; r < 4; ++r) { const int c = 16 * kt + r - 16 * nt; sc[kt][nt][r] = (dq <= -c) ? sc[kt][nt][r] : -1.0e30f; }
                }
            }
            float mx[4]; bool need = false;
#pragma unroll
            for (int nt = 0; nt < 4; ++nt) { mx[nt] = fmaxf(fmaxf(fmaxf(sc[0][nt][0], sc[0][nt][1]), fmaxf(sc[0][nt][2], sc[0][nt][3])), fmaxf(fmaxf(sc[1][nt][0], sc[1][nt][1]), fmaxf(sc[1][nt][2], sc[1][nt][3])));
                need = need || (mx[nt] > mu[nt] + 8.0f); }
            if (__builtin_amdgcn_ballot_w64(need) != 0ull) {
#pragma unroll
                for (int nt = 0; nt < 4; ++nt) { float rm = fmaxf(mx[nt], bperm(lane ^ 16, mx[nt])); rm = fmaxf(rm, bperm(lane ^ 32, rm));
                    const float mn = fmaxf(mu[nt], rm), f = __builtin_amdgcn_exp2f(mu[nt] - mn); mu[nt] = mn; lp[nt] *= f;
#pragma unroll
                    for (int dt = 0; dt < 4; ++dt) o[dt][nt] = o[dt][nt] * f; }
            }
            bf16x8_t pf[4];
#pragma unroll
            for (int nt = 0; nt < 4; ++nt) { float pv[8];
#pragma unroll
                for (int e = 0; e < 8; ++e) { pv[e] = __builtin_amdgcn_exp2f(sc[e >> 2][nt][e & 3] - mu[nt]); }
                const unsigned w0 = pg8::cvt_pk_bf16(pv[0], pv[1]), w1 = pg8::cvt_pk_bf16(pv[2], pv[3]), w2 = pg8::cvt_pk_bf16(pv[4], pv[5]), w3 = pg8::cvt_pk_bf16(pv[6], pv[7]);
                lp[nt] += (__uint_as_float(w0 << 16) + __uint_as_float(w0 & 0xffff0000u)) + (__uint_as_float(w1 << 16) + __uint_as_float(w1 & 0xffff0000u))
                        + (__uint_as_float(w2 << 16) + __uint_as_float(w2 & 0xffff0000u)) + (__uint_as_float(w3 << 16) + __uint_as_float(w3 & 0xffff0000u));
                v4u pw; pw.x = w0; pw.y = w1; pw.z = w2; pw.w = w3; pf[nt] = __builtin_bit_cast(bf16x8_t, pw); }
#pragma unroll
            for (int dt = 0; dt < 4; ++dt) { const LAS unsigned char* vp = lds + ATT_V + (16 * dt + fr) * ATT_VP + (kb * 32 + 4 * fq) * 2;
                const u32x2 lo = *(const LAS u32x2*)vp, hi = *(const LAS u32x2*)(vp + 32); v4u vw; vw.x = lo.x; vw.y = lo.y; vw.z = hi.x; vw.w = hi.y; const bf16x8_t vf = __builtin_bit_cast(bf16x8_t, vw);
#pragma unroll
                for (int nt = 0; nt < 4; ++nt) o[dt][nt] = __builtin_amdgcn_mfma_f32_16x16x32_bf16(vf, pf[nt], o[dt][nt], 0, 0, 0); }
        }
    }
#pragma unroll
    for (int nt = 0; nt < 4; ++nt) { float l = lp[nt] + bperm(lane ^ 16, lp[nt]); l += bperm(lane ^ 32, l); const float inv = 1.0f / l;
        bf16_t* orow = BO + (trow0 + 64 * hf + 16 * nt + fr) * ABR_LD + h * HD + 4 * fq;
#pragma unroll
        for (int dt = 0; dt < 4; ++dt) { u32x2 w2_; w2_.x = pg8::cvt_pk_bf16(o[dt][nt][0] * inv, o[dt][nt][1] * inv); w2_.y = pg8::cvt_pk_bf16(o[dt][nt][2] * inv, o[dt][nt][3] * inv); *(u32x2*)(orow + 16 * dt) = w2_; } }
}
constexpr int SGU_PITCH = 272, SGU_T0 = 0, SGU_T1 = 34816, SGU_ST = 69632;
__device__ __forceinline__ void sgu_unit(int q, int pass0, int tl, LAS unsigned char* lds, const bf16_t* P, const float* lng, const float* lnb, const bf16_t* Wsp, const float* bsp, bf16_t* AO) {
    constexpr int CPB = Dims::TPB / CHUNK;
    const size_t t0 = (size_t)(q / CPB) * Dims::TPB + (size_t)(q % CPB) * CHUNK;
    const int lane = tl & 63, w = tl >> 6, fr = lane & 15, fq = lane >> 4;
    LAS float* stat = (LAS float*)(lds + SGU_ST);
    __syncthreads();
    {
        v4u raw[16]; float mean[16];
#pragma unroll
        for (int k = 0; k < 16; ++k) raw[k] = *(const v4u*)(P + (t0 + 16 * w + k) * IN_W + OFF_V + 8 * lane);
        __builtin_amdgcn_sched_barrier(0);
#pragma unroll
        for (int k = 0; k < 16; ++k) { float sm = 0.f;
#pragma unroll
            for (int e = 0; e < 4; ++e) sm += __uint_as_float(raw[k][e] << 16) + __uint_as_float(raw[k][e] & 0xffff0000u);
            mean[k] = wave_sum(sm, lane) * (1.0f / SGU_W); }
#pragma unroll
        for (int k = 0; k < 16; ++k) { float qq = 0.f;
#pragma unroll
            for (int e = 0; e < 4; ++e) { const float d0 = __uint_as_float(raw[k][e] << 16) - mean[k], d1 = __uint_as_float(raw[k][e] & 0xffff0000u) - mean[k]; qq += d0 * d0 + d1 * d1; }
            const float rstd = 1.0f / sqrtf(wave_sum(qq, lane) * (1.0f / SGU_W) + LN_EPS);
            if (lane == 0) { stat[2 * (16 * w + k)] = mean[k]; stat[2 * (16 * w + k) + 1] = rstd; } } }
    __syncthreads();
    { const int pass = pass0;
        {
            const int cg = tl & 15, qg = (tl >> 4) & 15, gs = tl >> 8, g = 2 * pass + gs; LAS unsigned char* tile = lds + (gs ? SGU_T1 : SGU_T0);
            const float* gp = lng + g * SGU_GW + 8 * cg; const float* bp = lnb + g * SGU_GW + 8 * cg;
            const f32x4 g0 = *(const f32x4*)gp, g1 = *(const f32x4*)(gp + 4), b0 = *(const f32x4*)bp, b1 = *(const f32x4*)(bp + 4);
            const float gg[8] = {g0.x, g0.y, g0.z, g0.w, g1.x, g1.y, g1.z, g1.w}, bb[8] = {b0.x, b0.y, b0.z, b0.w, b1.x, b1.y, b1.z, b1.w};
            float vn[8][8];
#pragma unroll
            for (int k = 0; k < 8; ++k) { const int tok = 8 * qg + k; const v4u raw = *(const v4u*)(P + (t0 + tok) * IN_W + OFF_V + g * SGU_GW + 8 * cg); const float mean = stat[2 * tok], rstd = stat[2 * tok + 1];
#pragma unroll
                for (int e = 0; e < 4; ++e) { vn[k][2 * e] = (__uint_as_float(raw[e] << 16) - mean) * rstd * gg[2 * e] + bb[2 * e]; vn[k][2 * e + 1] = (__uint_as_float(raw[e] & 0xffff0000u) - mean) * rstd * gg[2 * e + 1] + bb[2 * e + 1]; } }
#pragma unroll
            for (int e = 0; e < 8; ++e) { v4u pk; pk.x = pk2(vn[0][e], vn[1][e]); pk.y = pk2(vn[2][e], vn[3][e]); pk.z = pk2(vn[4][e], vn[5][e]); pk.w = pk2(vn[6][e], vn[7][e]);
                *(LAS v4u*)(tile + (8 * cg + e) * SGU_PITCH + qg * 16) = pk; }
        }
        __syncthreads();
        {
            const int gs = w >> 2, g = 2 * pass + gs, mt0 = 2 * (w & 3); const LAS unsigned char* tile = lds + (gs ? SGU_T1 : SGU_T0);
            bf16x8_t af[2][4];
#pragma unroll
            for (int mi = 0; mi < 2; ++mi)
#pragma unroll
                for (int ks = 0; ks < 4; ++ks) af[mi][ks] = *(const LAS bf16x8_t*)(tile + (16 * (mt0 + mi) + fr) * SGU_PITCH + (32 * ks + 8 * fq) * 2);
            const bf16_t* wg_ = Wsp + (size_t)g * CHUNK * CHUNK;
            u32x2 uu[8][2]; float bs[8];
#pragma unroll
            for (int nt = 0; nt < 8; ++nt) { const int p = 16 * nt + fr; bs[nt] = bsp[g * CHUNK + p];
#pragma unroll
                for (int mi = 0; mi < 2; ++mi) uu[nt][mi] = *(const u32x2*)(P + (t0 + p) * IN_W + OFF_U + g * SGU_GW + 16 * (mt0 + mi) + 4 * fq); }
#pragma unroll
            for (int nh = 0; nh < 2; ++nh) { bf16x8_t bfr[4][4];
#pragma unroll
                for (int n4 = 0; n4 < 4; ++n4)
#pragma unroll
                    for (int ks = 0; ks < 4; ++ks) bfr[n4][ks] = *(const bf16x8_t*)(wg_ + (size_t)(16 * (4 * nh + n4) + fr) * CHUNK + 32 * ks + 8 * fq);
                __builtin_amdgcn_sched_barrier(0);
#pragma unroll
                for (int n4 = 0; n4 < 4; ++n4) { const int nt = 4 * nh + n4; f32x4 acc0 = {0.f, 0.f, 0.f, 0.f}, acc1 = {0.f, 0.f, 0.f, 0.f};
#pragma unroll
                    for (int ks = 0; ks < 4; ++ks) { acc0 = __builtin_amdgcn_mfma_f32_16x16x32_bf16(af[0][ks], bfr[n4][ks], acc0, 0, 0, 0); acc1 = __builtin_amdgcn_mfma_f32_16x16x32_bf16(af[1][ks], bfr[n4][ks], acc1, 0, 0, 0); }
                    const size_t trow = t0 + 16 * nt + fr; const float b_ = bs[nt];
#pragma unroll
                    for (int mi = 0; mi < 2; ++mi) { const f32x4 a = mi ? acc1 : acc0; const int c = g * SGU_GW + 16 * (mt0 + mi) + 4 * fq; const f32x4 uf = unpk4(uu[nt][mi]);
                        u32x2 ow; ow.x = pk2(uf.x * (a.x + b_), uf.y * (a.y + b_)); ow.y = pk2(uf.z * (a.z + b_), uf.w * (a.w + b_)); *(u32x2*)(AO + trow * ABR_LD + c) = ow; } }
                __builtin_amdgcn_sched_barrier(0); }
        }
        __syncthreads();
    }
}
__device__ __forceinline__ void mod_unit(int u, int tl, LAS unsigned char* lds, const float* c, const float* c_ctx, const float* w_mod, const float* b_mod, float* MOD) {
    LAS float* sl = (LAS float*)lds; LAS float* part = (LAS float*)(lds + 16384);
    __syncthreads();
    for (int i = tl; i < 3 * D; i += 512) { const float v = i < 2 * D ? c[i] : c_ctx[i - 2 * D]; sl[i] = v / (1.0f + __expf(-v)); }
    __syncthreads();
    const int jl4 = tl & 31, kq = tl >> 5, l = u / (NMOD * D / 128), j = (u % (NMOD * D / 128)) * 128 + 4 * jl4;
    const float* w = w_mod + ((size_t)l * D + 64 * kq) * NMOD * D + j; f32x4 a0 = {0.f, 0.f, 0.f, 0.f}, a1 = a0, a2 = a0;
#pragma unroll 8
    for (int k = 0; k < 64; ++k) { const f32x4 wv = *(const f32x4*)(w + (size_t)k * NMOD * D); a0 += sl[64 * kq + k] * wv; a1 += sl[D + 64 * kq + k] * wv; a2 += sl[2 * D + 64 * kq + k] * wv; }
    *(LAS f32x4*)(part + (kq * 3 + 0) * 128 + 4 * jl4) = a0; *(LAS f32x4*)(part + (kq * 3 + 1) * 128 + 4 * jl4) = a1; *(LAS f32x4*)(part + (kq * 3 + 2) * 128 + 4 * jl4) = a2;
    __syncthreads();
    if (tl < 3 * 128) { const int r = tl >> 7, jl = tl & 127; float sum = 0.f;
#pragma unroll
        for (int q = 0; q < 16; ++q) sum += part[(q * 3 + r) * 128 + jl];
        MOD[((size_t)l * (NB + 1) + r) * NMOD * D + (u % (NMOD * D / 128)) * 128 + jl] = sum + b_mod[(size_t)l * NMOD * D + (u % (NMOD * D / 128)) * 128 + jl]; }
}
template <bool WT> __device__ __forceinline__ void merge8_t(size_t t, int c8, const bf16_t* P, const bf16_t* PS, bf16_t* Y);
__device__ __forceinline__ void merge8(size_t i, const bf16_t* P, const bf16_t* PS, bf16_t* Y) { merge8_t<false>(i >> 7, (int)(i & 127) * 8, P, PS, Y); }
struct M8 { v4u ga, gb, gr, p0, p1, p2, p3; };
__device__ __forceinline__ M8 merge8_load(size_t t, int c8, const bf16_t* P, const bf16_t* PS) {
    const bf16_t* g = P + t * IN_W + OFF_G + c8; const bf16_t* ps = PS + t * D + c8; constexpr size_t SS = (size_t)Dims::T * D;
    return M8{*(const v4u*)g, *(const v4u*)(g + D), *(const v4u*)(g + 2 * D), *(const v4u*)ps, *(const v4u*)(ps + SS), *(const v4u*)(ps + 2 * SS), *(const v4u*)(ps + 3 * SS)};
}
template <bool WT> __device__ __forceinline__ void merge8_fin(const M8& m8, size_t t, int c8, bf16_t* Y);
template <bool WT> __device__ __forceinline__ void merge8_t(size_t t, int c8, const bf16_t* P, const bf16_t* PS, bf16_t* Y) { const M8 m8 = merge8_load(t, c8, P, PS); merge8_fin<WT>(m8, t, c8, Y); }
template <bool WT> __device__ __forceinline__ void merge8_fin(const M8& m8, size_t t, int c8, bf16_t* Y) {
    const v4u ga = m8.ga, gb = m8.gb, gr = m8.gr, p0 = m8.p0, p1 = m8.p1, p2 = m8.p2, p3 = m8.p3;
    v4u o;
#pragma unroll
    for (int e = 0; e < 4; ++e) {
        const float lo = fast_sigmoid(__uint_as_float(ga[e] << 16)) * __uint_as_float(p0[e] << 16) + fast_sigmoid(__uint_as_float(gb[e] << 16)) * __uint_as_float(p1[e] << 16)
                       + fast_sigmoid(__uint_as_float(gr[e] << 16)) * (__uint_as_float(p2[e] << 16) + __uint_as_float(p3[e] << 16));
        const float hi = fast_sigmoid(__uint_as_float(ga[e] & 0xffff0000u)) * __uint_as_float(p0[e] & 0xffff0000u) + fast_sigmoid(__uint_as_float(gb[e] & 0xffff0000u)) * __uint_as_float(p1[e] & 0xffff0000u)
                       + fast_sigmoid(__uint_as_float(gr[e] & 0xffff0000u)) * (__uint_as_float(p2[e] & 0xffff0000u) + __uint_as_float(p3[e] & 0xffff0000u));
        o[e] = pk2(lo, hi); }
    if (WT) { unsigned long long* yp = (unsigned long long*)(Y + t * D + c8);
        __hip_atomic_store(yp, (unsigned long long)o.x | ((unsigned long long)o.y << 32), __ATOMIC_RELAXED, __HIP_MEMORY_SCOPE_AGENT);
        __hip_atomic_store(yp + 1, (unsigned long long)o.z | ((unsigned long long)o.w << 32), __ATOMIC_RELAXED, __HIP_MEMORY_SCOPE_AGENT); }
    else *(v4u*)(Y + t * D + c8) = o;
}
template <int CTRL> __device__ __forceinline__ float dpp_mov(float v) { return __int_as_float(__builtin_amdgcn_update_dpp(0, __float_as_int(v), CTRL, 0xf, 0xf, false)); }
__device__ __forceinline__ float row_sum16(float v) { v += dpp_mov<0x128>(v); v += dpp_mov<0x124>(v); v += dpp_mov<0x122>(v); v += dpp_mov<0x121>(v); return v; }
__device__ __forceinline__ void ln1_route_quad(int t, int lane, const float* X, const float* xin, const float* cin, float* X1, const float* YO, const float* MODl, const float* g1, const float* b1, float alpha, bf16_t* Hb,
                                               const float* wg, const float* bg, const LAS float* wrl, const float* brt, LAS int* lcnt, LAS int* rec, float* tokgate) {
    const int l16 = lane & 15, b = t / Dims::TPB, p = t % Dims::TPB, row = p < CTX ? NB : b;
    const float* m = MODl + (size_t)row * NMOD * D; float* xw = X1 + (size_t)t * D; const float* yr = YO + (size_t)t * D;
    const float* xr = xin ? (p < CTX ? cin + ((size_t)b * CTX + p) * D : xin + ((size_t)b * Dims::S + (p - CTX)) * D) : X + (size_t)t * D;
    f32x4 v[16]; float s = 0.f;
#pragma unroll
    for (int h = 0; h < 2; ++h) { f32x4 xa[8], ya[8], ma[8];
#pragma unroll
        for (int jj = 0; jj < 8; ++jj) { const int c = 64 * (8 * h + jj) + 4 * l16; xa[jj] = *(const f32x4*)(xr + c); ya[jj] = *(const f32x4*)(yr + c); ma[jj] = *(const f32x4*)(m + 2 * D + c); }
        __builtin_amdgcn_sched_barrier(0);
#pragma unroll
        for (int jj = 0; jj < 8; ++jj) { v[8 * h + jj] = alpha * xa[jj] + ma[jj] * ya[jj]; s += hsum4(v[8 * h + jj]); }
        __builtin_amdgcn_sched_barrier(0); }
    const float mean = row_sum16(s) * (1.0f / D); float q = 0.f;
#pragma unroll
    for (int j = 0; j < 16; ++j) { v[j] = v[j] - mean; q += hsum4(v[j] * v[j]); }
    const float rstd = 1.0f / sqrtf(row_sum16(q) * (1.0f / D) + LN_EPS);
    float gl[4] = {0.f, 0.f, 0.f, 0.f};
    f32x4 cg, cb, c4, c3;
    { const int c = 4 * l16; cg = *(const f32x4*)(g1 + c); cb = *(const f32x4*)(b1 + c); c4 = *(const f32x4*)(m + 4 * D + c); c3 = *(const f32x4*)(m + 3 * D + c); }
#pragma unroll
    for (int j = 0; j < 16; ++j) { const int c = 64 * j + 4 * l16, cn = c + 64;
        f32x4 ng = cg, nb = cb, n4 = c4, n3 = c3;
        if (j < 15) { ng = *(const f32x4*)(g1 + cn); nb = *(const f32x4*)(b1 + cn); n4 = *(const f32x4*)(m + 4 * D + cn); n3 = *(const f32x4*)(m + 3 * D + cn); }
        __builtin_amdgcn_sched_barrier(0);
        const f32x4 xn = v[j] * rstd * cg + cb; *(f32x4*)(xw + c) = xn;
        v[j] = xn * (1.0f + c4) + c3;
        *(u32x2*)(Hb + (size_t)t * D + c) = pk4(v[j]);
        __builtin_amdgcn_sched_barrier(0);
        cg = ng; cb = nb; c4 = n4; c3 = n3; }
#pragma unroll
    for (int h = 0; h < 4; ++h) { f32x4 wa[4][4];
#pragma unroll
        for (int jj = 0; jj < 4; ++jj)
#pragma unroll
            for (int e = 0; e < 4; ++e) wa[jj][e] = *(const f32x4*)(wg + (size_t)(64 * (4 * h + jj) + 4 * l16 + e) * NGRP);
        __builtin_amdgcn_sched_barrier(0);
#pragma unroll
        for (int jj = 0; jj < 4; ++jj)
#pragma unroll
            for (int e = 0; e < 4; ++e) { const f32x4 w = wa[jj][e]; const float hv = v[4 * h + jj][e]; gl[0] += hv * w.x; gl[1] += hv * w.y; gl[2] += hv * w.z; gl[3] += hv * w.w; }
        __builtin_amdgcn_sched_barrier(0); }
#pragma unroll
    for (int i = 0; i < 4; ++i) gl[i] = row_sum16(gl[i]) + bg[i];
    int gi = 0; float gm = gl[0]; if (gl[1] > gm) { gm = gl[1]; gi = 1; } if (gl[2] > gm) { gm = gl[2]; gi = 2; } if (gl[3] > gm) { gm = gl[3]; gi = 3; }
    const float gw = 1.0f / (expf(gl[0] - gm) + expf(gl[1] - gm) + expf(gl[2] - gm) + expf(gl[3] - gm));
    float ev[8] = {0.f, 0.f, 0.f, 0.f, 0.f, 0.f, 0.f, 0.f};
#pragma unroll
    for (int j = 0; j < 16; ++j)
#pragma unroll
        for (int e = 0; e < 4; ++e) { const LAS float* wp = wrl + ((gi * D + 64 * j + 16 * e + l16) * 4); const f32x4 w0 = *(const LAS f32x4*)wp, w1 = *(const LAS f32x4*)(wp + NGRP * D * 4); const float hv = v[j][e];
            ev[0] += hv * w0.x; ev[1] += hv * w0.y; ev[2] += hv * w0.z; ev[3] += hv * w0.w; ev[4] += hv * w1.x; ev[5] += hv * w1.y; ev[6] += hv * w1.z; ev[7] += hv * w1.w; }
#pragma unroll
    for (int i = 0; i < 8; ++i) ev[i] = row_sum16(ev[i]) + brt[gi * EPG + i];
    int j0 = 0; float v0 = ev[0];
#pragma unroll
    for (int i = 1; i < 8; ++i) if (ev[i] > v0) { v0 = ev[i]; j0 = i; }
    int j1 = -1; float v1 = -3.0e38f;
#pragma unroll
    for (int i = 0; i < 8; ++i) if (i != j0 && ev[i] > v1) { v1 = ev[i]; j1 = i; }
    if (l16 == 0) {
        const float p1 = expf(v1 - v0), inv = 1.0f / (1.0f + p1); const int e0 = gi * EPG + j0, e1 = gi * EPG + j1;
        const int lp0 = __hip_atomic_fetch_add(lcnt + e0, 1, __ATOMIC_RELAXED, __HIP_MEMORY_SCOPE_WORKGROUP), lp1 = __hip_atomic_fetch_add(lcnt + e1, 1, __ATOMIC_RELAXED, __HIP_MEMORY_SCOPE_WORKGROUP);
        rec[0] = t; rec[1] = e0; rec[2] = lp0; rec[3] = e1; rec[4] = lp1;
        *(float2*)(tokgate + (size_t)t * 2) = make_float2(gw * inv, gw * p1 * inv);
    }
}
__device__ __forceinline__ void combine_ln2_quad(int t, int lane, const float* X1, float* X, const bf16_t* O, const LAS int* tst, const int* tokinfo, const float* tokgate, const LAS float* vec, bool has_next,
                                                 float alpha, bf16_t* Hb, float* out) {
    const int l16 = lane & 15, b = t / Dims::TPB, p = t % Dims::TPB, row = p < CTX ? NB : b;
    const LAS float* g2 = vec; const LAS float* b2 = vec + D; const LAS float* m = vec + 2 * D + row * 3 * D; const LAS float* mn = m + D;
    const float* xr = X1 + (size_t)t * D; float* xw = X + (size_t)t * D;
    const int4 ti = *(const int4*)(tokinfo + (size_t)t * 4); const float2 tg = *(const float2*)(tokgate + (size_t)t * 2);
    const bf16_t* o0 = O + ((size_t)256 * tst[ti.x] + ti.y) * D; const bf16_t* o1 = O + ((size_t)256 * tst[ti.z] + ti.w) * D;
    f32x4 v[16]; float s = 0.f;
#pragma unroll
    for (int h = 0; h < 2; ++h) { f32x4 xa[8]; u32x2 oa[8], ob[8];
#pragma unroll
        for (int jj = 0; jj < 8; ++jj) { const int c = 64 * (8 * h + jj) + 4 * l16; xa[jj] = *(const f32x4*)(xr + c); oa[jj] = *(const u32x2*)(o0 + c); ob[jj] = *(const u32x2*)(o1 + c); }
        __builtin_amdgcn_sched_barrier(0);
#pragma unroll
        for (int jj = 0; jj < 8; ++jj) { const int j = 8 * h + jj, c = 64 * j + 4 * l16; const f32x4 f = tg.x * unpk4(oa[jj]) + tg.y * unpk4(ob[jj]);
            v[j] = alpha * xa[jj] + *(const LAS f32x4*)(m + c) * f; s += hsum4(v[j]); }
        __builtin_amdgcn_sched_barrier(0); }
    const float mean = row_sum16(s) * (1.0f / D); float q = 0.f;
#pragma unroll
    for (int j = 0; j < 16; ++j) { v[j] = v[j] - mean; q += hsum4(v[j] * v[j]); }
    const float rstd = __builtin_amdgcn_rsqf(row_sum16(q) * (1.0f / D) + LN_EPS);
#pragma unroll
    for (int j = 0; j < 16; ++j) { const int c = 64 * j + 4 * l16;
        const f32x4 xn = v[j] * rstd * *(const LAS f32x4*)(g2 + c) + *(const LAS f32x4*)(b2 + c);
        if (has_next) *(f32x4*)(xw + c) = xn;
        if (has_next) *(u32x2*)(Hb + (size_t)t * D + c) = pk4(xn * (1.0f + *(const LAS f32x4*)(mn + D + c)) + *(const LAS f32x4*)(mn + c));
        else if (p >= CTX) *(f32x4*)(out + ((size_t)b * Dims::S + (p - CTX)) * D + c) = xn; }
}
__device__ __forceinline__ void build_tst(const int* cnt, LAS int* tst, LAS int* cntl) {
    __syncthreads();
    const int tl = ltid();
    if (tl < 32) cntl[tl] = cnt[tl * CNT_STRIDE];
    __syncthreads();
    if (tl < 33) { int acc = 0; for (int e = 0; e < tl; ++e) acc += (cntl[e] + 255) / 256; tst[tl] = acc; }
    __syncthreads();
}
#endif

#ifdef CPU_SHIM
#define PROG_FN static void
#define DUP_BEGIN(k) { const int rep_ = 0; (void)rep_;
#define DUP_END }
#define PHASE_ARGS()
#define RUN_ITEMS(n, ...) cpu_items((size_t)(n), [&](size_t gi_) { __VA_ARGS__; })
#define GRID_SYNC() do { } while (0)
#define PROG_PARAMS const In& in, const Bufs& B, float* out, const Dims dm
#define GEMM_PHASE(EPI_T, EPI_ARGS, Ab, Wt, Wf32, M_, N_, K_, bias, Cf, Cb, ldc) RUN_ITEMS((size_t)(M_) * (N_), d_gemm_ref(gi_, Ab, K_, Wf32, N_, bias, Cf, Cb, ldc, N_, K_))
#else
typedef const __attribute__((address_space(4))) Args KArgs;
typedef const __attribute__((address_space(4))) In KIn;
typedef const __attribute__((address_space(4))) Bufs KBufs;
__device__ __forceinline__ KArgs* argp() { KArgs* p = (KArgs*)__builtin_amdgcn_kernarg_segment_ptr(); asm volatile("" : "+s"(p)); return p; }
#define PROG_FN __device__ __forceinline__ void
#ifndef PROBE_DUP
#define PROBE_DUP (-1)
#endif
#define DUP_BEGIN(k) for (int rep_ = 0; rep_ < ((k) == PROBE_DUP ? 2 : 1); ++rep_) {
#define DUP_END }
#if defined(PROBE_K1)
#define PROBE_STAMP() do { if (blockIdx.x == 0 && threadIdx.x == 0) { unsigned long long* ts_ = (unsigned long long*)(argp()->ws + 32768); const unsigned n_ = (unsigned)ts_[0]; ts_[1 + n_] = wall_clock64(); ts_[0] = n_ + 1; } } while (0)
#else
#define PROBE_STAMP() do { } while (0)
#endif
#define PHASE_ARGS() KArgs* A_ = argp(); KIn& in = A_->in; KBufs& B = A_->B; float* const out = A_->out; (void)in; (void)B; (void)out
#define RUN_ITEMS(n, ...) do { PHASE_ARGS(); const size_t g0_ = (size_t)blockIdx.x * 512 + ltid(), gstride = (size_t)NWG * 512; for (size_t gi_ = g0_; gi_ < (size_t)(n); gi_ += gstride) { __VA_ARGS__; } } while (0)
#define GRID_SYNC() do { XcdBarrier b_ = bar; b_.bar = (unsigned*)(argp()->ws + WS_CTL); { unsigned x_ = b_.x; asm volatile("" : "+s"(x_)); b_.x = x_; } xcd_barrier(b_); PROBE_STAMP(); } while (0)
#define PROG_PARAMS const Dims dm, const XcdBarrier& bar, LAS unsigned char* lds
#define GEMM_PHASE(EPI_T, EPI_ARGS, Ab, Wt, Wf32, M_, N_, K_, bias, Cf, Cb, ldc) do { PHASE_ARGS(); pg8::Gemm g_{Ab, Wt, M_, N_, K_}; pg8::StaticOrder S_; S_.init(M_, N_, NWG, (int)blockIdx.x); \
    const EPI_T E_ = pg8::mk<EPI_T> EPI_ARGS; pg8::gemm_phase(lds + RING_OFF, g_, S_, E_); } while (0)
#endif
#define GEMM_ITEMS(A, lda, arow, B, ldb, bstride, blk_e, bias, C, ldc, M, N, K) \
    RUN_ITEMS((size_t)((M) / 4) * ((N) / 4), d_gemm(gi_, A, lda, arow, B, ldb, bstride, blk_e, bias, C, ldc, M, N, K))

PROG_FN forward_program(PROG_PARAMS) {
    const size_t T = dm.T;
    const float ALPHA = sqrtf(sqrtf(2.0f * (float)dm.L));

    DUP_BEGIN(0)
#ifndef CPU_SHIM
    {
        PHASE_ARGS();
        const int tl = ltid(), lane = tl & 63, wave = tl >> 6, gw = blockIdx.x * 8 + wave, NGW = NWG * 8;
        LAS float* scr = (LAS float*)(lds + RING_OFF + wave * 16384);
        const int I_IN = (D / 64) * (IN_W / 32), I_A = (SGU_W / 64) * (D / 32), I_B = (ATT_W / 64) * (D / 32), I_C = (LRU_W / 64) * (D / 32), I_O = (D / 64) * (D / 32);
        const int per_l = I_IN + I_A + I_B + I_C + I_O;
        for (int it = gw; it < per_l * dm.L; it += NGW) {
            const int l = it / per_l; int r = it % per_l;
            if (r < I_IN) { p0_transpose_item(in.w_in + (size_t)l * D * IN_W, D, IN_W, B.Win_t + (size_t)l * IN_W * D, scr, r, lane); continue; } r -= I_IN;
            if (r < I_A) { p0_transpose_item_ld(in.w_proj_a + (size_t)l * SGU_W * D, SGU_W, D, B.Wabc_t + (size_t)l * D * ABR_LD, ABR_LD, scr, r, lane); continue; } r -= I_A;
            if (r < I_B) { p0_transpose_item_ld(in.w_proj_b + (size_t)l * ATT_W * D, ATT_W, D, B.Wabc_t + (size_t)l * D * ABR_LD + SGU_W, ABR_LD, scr, r, lane); continue; } r -= I_B;
            if (r < I_C) { p0_transpose_item_ld(in.w_proj_c + (size_t)l * LRU_W * D, LRU_W, D, B.Wabc_t + (size_t)l * D * ABR_LD + SGU_W + ATT_W, ABR_LD, scr, r, lane); continue; } r -= I_C;
            p0_transpose_item(in.w_out + (size_t)l * D * D, D, D, B.Wo_t + (size_t)l * D * D, scr, r, lane);
        }
        for (int it = gw; it < 2 * dm.L * 16 * 8; it += NGW) {
            const int gsel = it / (dm.L * 16 * 8), r = it % (dm.L * 16 * 8), mi = r / 8, ti = r % 8;
            p0_transpose_item((gsel ? in.w_igate : in.w_rgate) + (size_t)mi * LRU_BW * LRU_BW, LRU_BW, LRU_BW, (gsel ? B.Wi_t : B.Wr_t) + (size_t)mi * LRU_BW * LRU_BW, scr, ti, lane);
        }
    }
#endif
#ifdef CPU_SHIM
    RUN_ITEMS((size_t)dm.L * NMOD * D, d_mod(gi_, in.c, in.c_ctx, in.w_mod, in.b_mod, B.MOD, dm));
#else
    { PHASE_ARGS(); const int tl = ltid(); for (int u = (int)blockIdx.x; u < Dims::L * NMOD * D / 128; u += NWG) mod_unit(u, tl, lds, in.c, in.c_ctx, in.w_mod, in.b_mod, B.MOD); __syncthreads(); }
#endif
    RUN_ITEMS((size_t)dm.L * 2 * LRU_W, B.CCH[gi_] = -8.0f * softplus_neg(in.lru_lambda[gi_]));
    RUN_ITEMS(128 * 16, d_rope_table(gi_, B.ROPE));
#ifndef CPU_SHIM
    RUN_ITEMS((size_t)dm.L * 4 * CHUNK * CHUNK, B.Wsp_b[gi_] = f2bf(in.w_spatial[gi_]));
#endif
#ifdef CPU_SHIM
    RUN_ITEMS(T * D, d_init_x(gi_, in.x, in.ctx, B.X, dm));
#endif
    GRID_SYNC();
    DUP_END
    for (int l = 0; l < dm.L; ++l) {
        const bool lastl_ = (l + 1 == dm.L); (void)lastl_;
#ifdef CPU_SHIM
        if (l == 0) { RUN_ITEMS(T * D, d_modulate_bf(gi_, B.X, B.MOD, B.Hb, 0, dm)); GRID_SYNC(); }
#else
        if (l == 0) { PHASE_ARGS(); const size_t g0_ = (size_t)blockIdx.x * 512 + ltid(), gs_ = (size_t)NWG * 512, n_ = T * (D / 4);
            for (size_t gi0 = g0_; gi0 < n_; gi0 += 4 * gs_) { f32x4 xv[4], ms[4], mh[4];
#pragma unroll
                for (int u_ = 0; u_ < 4; ++u_) { const size_t gi_ = gi0 + u_ * gs_ < n_ ? gi0 + u_ * gs_ : g0_;
                    const int t_ = (int)(gi_ >> 8), c_ = (int)(gi_ & 255) * 4, b_ = t_ / Dims::TPB, p_ = t_ % Dims::TPB; const float* m_ = B.MOD + (size_t)(p_ < CTX ? NB : b_) * NMOD * D;
                    xv[u_] = *(const f32x4*)((p_ < CTX ? in.ctx + ((size_t)b_ * CTX + p_) * D : in.x + ((size_t)b_ * Dims::S + (p_ - CTX)) * D) + c_); ms[u_] = *(const f32x4*)(m_ + D + c_); mh[u_] = *(const f32x4*)(m_ + c_); }
                __builtin_amdgcn_sched_barrier(0);
#pragma unroll
                for (int u_ = 0; u_ < 4; ++u_) { const size_t gi_ = gi0 + u_ * gs_; if (gi_ < n_) *(u32x2*)(B.Hb + (gi_ >> 8) * D + (gi_ & 255) * 4) = pk4(xv[u_] * (1.0f + ms[u_]) + mh[u_]); } }
            GRID_SYNC(); }
#endif
        DUP_BEGIN(1)
#ifdef CPU_SHIM
        GEMM_PHASE(pg8::EpiBf16, (B.P, IN_W, in.b_in + (size_t)l * IN_W, 0x7fffffff, (size_t)0), B.Hb, B.Win_t + (size_t)l * IN_W * D, in.w_in + (size_t)l * D * IN_W, (int)T, IN_W, D,
                   in.b_in + (size_t)l * IN_W, (float*)nullptr, B.P, IN_W);
        RUN_ITEMS(T * (IN_W / 2), d_inproj_act(gi_, B.P, B.VT, B.ROPE, dm));
#else
        { PHASE_ARGS(); const int tl = ltid();
          *(LAS f32x4*)(lds + MISC_OFF + 1024 + 4096 + tl * 16) = *(const f32x4*)((const float*)B.ROPE + (tl >> 8) * 2048 + (tl & 255) * 4); __syncthreads(); }
        GEMM_PHASE(EpiInProj, (B.P, in.b_in + (size_t)l * IN_W, B.VT, (const float*)B.ROPE, lds + MISC_OFF + 1024), B.Hb, B.Win_t + (size_t)l * IN_W * D, in.w_in + (size_t)l * D * IN_W, (int)T, IN_W, D,
                   in.b_in + (size_t)l * IN_W, (float*)nullptr, B.P, IN_W);
#endif
        GRID_SYNC();
        DUP_END
        DUP_BEGIN(3)
        {
            PHASE_ARGS();
            const float* cwl = in.conv_w + (size_t)l * 2 * 4 * LRU_W; const float* cbl = in.conv_b + l * 2 * LRU_W; const float* brl = in.b_rgate + l * 2 * LRU_W; const float* bil = in.b_igate + l * 2 * LRU_W;
            const float* lml = B.CCH + l * 2 * LRU_W;
#ifdef CPU_SHIM
            RUN_ITEMS((size_t)2 * (T / CHUNK) * LRU_W, d_lru_local_ref(gi_, B.P, cwl, cbl, in.w_rgate + (size_t)l * 2 * 8 * LRU_BW * LRU_BW, brl, in.w_igate + (size_t)l * 2 * 8 * LRU_BW * LRU_BW, bil, lml,
                      B.HL, B.AC, B.SUMA, B.SUMH, dm));
#else
            const int tl = ltid(); const bf16_t* wrt_ = B.Wr_t + (size_t)l * 2 * 8 * LRU_BW * LRU_BW; const bf16_t* wit_ = B.Wi_t + (size_t)l * 2 * 8 * LRU_BW * LRU_BW;
            static_assert(3 * NEXP * 256 == 16 * (NWG - 64) * 8 && (Dims::T / CHUNK) * 16 == 8 * NWG + 64, "conversion share: 16 tiles per wave of workgroups 64..255");
            int k_ = 0;
            for (int u = (int)blockIdx.x; u < (Dims::T / CHUNK) * 16; u += NWG, ++k_) {
                if ((int)blockIdx.x >= 64 && k_ == (((int)blockIdx.x >> 3) & 7)) {
                    __syncthreads();
                    const int lane = tl & 63, wave = tl >> 6; LAS float* scr = (LAS float*)(lds + RING_OFF + wave * 16384); const size_t ws1 = (size_t)D * DEXP * NEXP; constexpr int NCW = (NWG - 64) * 8;
                    for (int it = ((int)blockIdx.x - 64) * 8 + wave; it < 3 * NEXP * 256; it += 2 * NCW) {
                        const TileSrc ta = moe_weight_tile(in.w1 + (size_t)l * ws1, in.w3 + (size_t)l * ws1, in.w2 + (size_t)l * ws1, B.W13_t, B.W2_t, it);
                        const TileSrc tb = moe_weight_tile(in.w1 + (size_t)l * ws1, in.w3 + (size_t)l * ws1, in.w2 + (size_t)l * ws1, B.W13_t, B.W2_t, it + NCW);
                        f32x4 va[8], vb[8]; tile_load(ta, lane, va); tile_load(tb, lane, vb); tile_store(ta, lane, va, scr); tile_store(tb, lane, vb, scr); }
                    __syncthreads();
                }
                if (u & 1) lru_local_unit<1>(u >> 4, (u >> 1) & 7, tl, lds, B.P, cwl, cbl, wrt_, brl, wit_, bil, lml, B.HL, B.AC, B.SUMA, B.SUMH);
                else       lru_local_unit<0>(u >> 4, (u >> 1) & 7, tl, lds, B.P, cwl, cbl, wrt_, brl, wit_, bil, lml, B.HL, B.AC, B.SUMA, B.SUMH);
            }
#endif
        }
        GRID_SYNC();
        DUP_END
        DUP_BEGIN(2)
#ifdef CPU_SHIM
        RUN_ITEMS(T, d_sgu_ln(gi_, B.P, in.sgu_ln_g + l * SGU_W, in.sgu_ln_b + l * SGU_W, B.VN, dm));
        RUN_ITEMS(T * SGU_W, d_sgu_mix(gi_, B.P, B.VN, in.w_spatial + (size_t)l * 4 * CHUNK * CHUNK, in.b_spatial + l * 4 * CHUNK, B.AO, dm));
#else
        { PHASE_ARGS(); const int tl = ltid();
          if ((int)blockIdx.x >= 8 && (int)blockIdx.x < 16) { lru_carry_unit((int)blockIdx.x - 8, tl, B.SUMA, B.SUMH, B.CARRY);
              asm volatile("s_waitcnt vmcnt(0)" ::: "memory"); __syncthreads();
              if (tl == 0) __hip_atomic_fetch_add((unsigned*)(A_->ws + WS_CARRYFLAG), 1u, __ATOMIC_RELAXED, __HIP_MEMORY_SCOPE_AGENT); } }
        { PHASE_ARGS(); const int tl = ltid();
          for (int u = NWG - 1 - (int)blockIdx.x; u < 2 * (Dims::T / CHUNK); u += NWG) {
              if (lastl_ && (u >> 1) % (Dims::TPB / CHUNK) < 2) continue;
              sgu_unit(u >> 1, u & 1, tl, lds, B.P, in.sgu_ln_g + l * SGU_W, in.sgu_ln_b + l * SGU_W, B.Wsp_b + (size_t)l * 4 * CHUNK * CHUNK, in.b_spatial + l * 4 * CHUNK, B.AO); } }
#endif
#ifdef CPU_SHIM
        RUN_ITEMS(T * NH, d_attn_ref(gi_, B.P, B.VT, in.attn_sink + l * NH, B.BO, dm));
#else
        { const bool fixfirst = (((int)blockIdx.x >> 3) & 1) && !((int)blockIdx.x >= 8 && (int)blockIdx.x < 16);
          for (int step = 0; step < 2; ++step) {
            if ((step == 0) != fixfirst) {
              PHASE_ARGS(); const int tl = ltid(); __syncthreads();
              for (int u = (int)blockIdx.x; u < (lastl_ ? 2 * NB * (Dims::TPB / CHUNK - 2) : 2 * NB * (Dims::TPB / CHUNK)); u += NWG) attn_unit(u, tl, lds, B.P, B.VT, in.attn_sink + l * NH, B.BO);
            } else {
              PHASE_ARGS(); const int tl = ltid();
              if (tl == 0) { unsigned* fl = (unsigned*)(A_->ws + WS_CARRYFLAG); unsigned* tmo = (unsigned*)(A_->ws + WS_CTL) + XB_TMO; const unsigned need = 8u * (unsigned)(l + 1); unsigned sp = 0;
                  while (__hip_atomic_load(fl, __ATOMIC_RELAXED, __HIP_MEMORY_SCOPE_AGENT) < need) { __builtin_amdgcn_s_sleep(2);
                      if ((++sp & 255u) == 0u) { if (xb_ld(tmo)) break; if (sp > XB_SPIN_CAP) { atomicAdd(tmo, 1u); break; } } }
                  __builtin_amdgcn_fence(__ATOMIC_ACQUIRE, "agent"); asm volatile("s_waitcnt vmcnt(0)" ::: "memory"); }
              __syncthreads();
              { constexpr int NR = (Dims::T + NWG * 8 - 1) / (NWG * 8); const int t0 = ((int)blockIdx.x * 8 + (tl >> 6)) * NR;
                if (t0 < (int)T) lru_fix_rows(t0, (int)T - t0 < NR ? (int)T - t0 : NR, tl & 63, B.P, B.HL, B.AC, B.CARRY, B.RO); }
            } } }
#endif
        GRID_SYNC();
        DUP_END
        DUP_BEGIN(4)
#ifdef CPU_SHIM
        RUN_ITEMS(T * LRU_W, d_lru_fix_ref(gi_, B.P, B.HL, B.AC, B.SUMA, B.SUMH, B.RO, dm));
#endif
        DUP_END
        DUP_BEGIN(5)
#ifdef CPU_SHIM
        RUN_ITEMS(T * D, d_gemm_ref(gi_, B.AO, ABR_LD, in.w_proj_a + (size_t)l * SGU_W * D, D, (const float*)nullptr, B.PA, (bf16_t*)nullptr, D, D, SGU_W));
        RUN_ITEMS(T * D, d_gemm_ref(gi_, B.BO, ABR_LD, in.w_proj_b + (size_t)l * ATT_W * D, D, (const float*)nullptr, B.PB, (bf16_t*)nullptr, D, D, ATT_W));
        RUN_ITEMS(T * D, d_gemm_ref(gi_, B.RO, ABR_LD, in.w_proj_c + (size_t)l * LRU_W * D, D, (const float*)nullptr, B.PC, (bf16_t*)nullptr, D, D, LRU_W));
#else
        { PHASE_ARGS(); const pg8::Gemm g_{B.AO, B.Wabc_t + (size_t)l * D * ABR_LD, (int)T, D, 512, ABR_LD, ABR_LD};
          const pg8::EpiBf16 E_{B.PS, D, nullptr, 0x7fffffff, (size_t)T * D};
          if (lastl_) { const pg8::LatentSliceOrder S_{NWG, (int)blockIdx.x, 2}; pg8::gemm_phase<pg8::EpiBf16, pg8::LatentSliceOrder, false>(lds + RING_OFF, g_, S_, E_); }
          else { pg8::SliceOrder S_; S_.T4.init((int)T, D, 1, 0); S_.G = NWG; S_.c = (int)blockIdx.x; pg8::gemm_phase<pg8::EpiBf16, pg8::SliceOrder, false>(lds + RING_OFF, g_, S_, E_); } }
#endif
        RUN_ITEMS(NEXP, B.cnt[gi_ * CNT_STRIDE] = 0);
        GRID_SYNC();
        DUP_END
        DUP_BEGIN(6)
#ifdef CPU_SHIM
        RUN_ITEMS(T * D, d_merge(gi_, B.P, B.PA, B.PB, B.PC, B.Y, dm));
#else
        if (lastl_) { PHASE_ARGS(); const size_t g0_ = (size_t)blockIdx.x * 512 + ltid(), gs_ = (size_t)NWG * 512, n_ = T * (D / 8);
            for (size_t ia = g0_; ia < n_; ia += 2 * gs_) { const size_t ib = ia + gs_ < n_ ? ia + gs_ : ia;
                const M8 ma_ = merge8_load(ia >> 7, (int)(ia & 127) * 8, B.P, B.PS), mb_ = merge8_load(ib >> 7, (int)(ib & 127) * 8, B.P, B.PS);
                __builtin_amdgcn_sched_barrier(0);
                merge8_fin<false>(ma_, ia >> 7, (int)(ia & 127) * 8, B.Y); if (ib != ia) merge8_fin<false>(mb_, ib >> 7, (int)(ib & 127) * 8, B.Y); } }
        else { PHASE_ARGS(); const int tl = ltid(); constexpr int TB256 = Dims::TPB / 256;
            for (int it = (int)blockIdx.x * 512 + tl; it < NB * CTX * (D / 8); it += NWG * 512) { const int r = it >> 7; merge8_t<true>((size_t)(r >> 8) * Dims::TPB + (r & 255), (it & 127) * 8, B.P, B.PS, B.Y); }
            asm volatile("s_waitcnt vmcnt(0)" ::: "memory"); __syncthreads();
            if (tl == 0) __hip_atomic_fetch_add((unsigned*)(A_->ws + WS_YCTXFLAG), 1u, __ATOMIC_RELAXED, __HIP_MEMORY_SCOPE_AGENT);
            if ((int)blockIdx.x < 8) {
                if (tl == 0) { unsigned* fl = (unsigned*)(A_->ws + WS_YCTXFLAG); unsigned* tmo = (unsigned*)(A_->ws + WS_CTL) + XB_TMO; const unsigned need = (unsigned)NWG * (unsigned)(l + 1); unsigned sp = 0;
                    while (__hip_atomic_load(fl, __ATOMIC_RELAXED, __HIP_MEMORY_SCOPE_AGENT) < need) { __builtin_amdgcn_s_sleep(2);
                        if ((++sp & 255u) == 0u) { if (xb_ld(tmo)) break; if (sp > XB_SPIN_CAP) { atomicAdd(tmo, 1u); break; } } }
                    __builtin_amdgcn_fence(__ATOMIC_ACQUIRE, "agent"); asm volatile("s_waitcnt vmcnt(0)" ::: "memory"); }
                __syncthreads();
                const pg8::Gemm g_{B.Y, B.Wo_t + (size_t)l * D * D, (int)T, D, D, 0, 0}; const pg8::OneTileOrder S_{((int)blockIdx.x >> 2) * TB256, (int)blockIdx.x & 3}; const pg8::EpiF32 E_{B.YO, D, in.b_out + l * D};
                pg8::gemm_phase<pg8::EpiF32, pg8::OneTileOrder, false>(lds + RING_OFF, g_, S_, E_);
            } else {
                constexpr size_t n_ = (size_t)NB * Dims::S * (D / 8), gs_ = (size_t)(NWG - 8) * 512;
                for (size_t ia = (size_t)((int)blockIdx.x - 8) * 512 + tl; ia < n_; ia += 2 * gs_) { const size_t ib = ia + gs_ < n_ ? ia + gs_ : ia, ra = ia >> 7, rb = ib >> 7;
                    const size_t ta = (ra / Dims::S) * Dims::TPB + CTX + (ra % Dims::S), tb = (rb / Dims::S) * Dims::TPB + CTX + (rb % Dims::S);
                    const M8 ma_ = merge8_load(ta, (int)(ia & 127) * 8, B.P, B.PS), mb_ = merge8_load(tb, (int)(ib & 127) * 8, B.P, B.PS);
                    __builtin_amdgcn_sched_barrier(0);
                    merge8_fin<false>(ma_, ta, (int)(ia & 127) * 8, B.Y); if (ib != ia) merge8_fin<false>(mb_, tb, (int)(ib & 127) * 8, B.Y); } }
        }
#endif
        GRID_SYNC();
        DUP_END
        DUP_BEGIN(7)
#ifndef CPU_SHIM
        if (lastl_) { PHASE_ARGS(); const pg8::Gemm g_{B.Y, B.Wo_t + (size_t)l * D * D, (int)T, D, D, 0, 0}; const pg8::LatentSliceOrder S_{NWG, (int)blockIdx.x, 0}; const pg8::EpiF32 E_{B.YO, D, in.b_out + l * D};
            pg8::gemm_phase<pg8::EpiF32, pg8::LatentSliceOrder, false>(lds + RING_OFF, g_, S_, E_); }
        else { PHASE_ARGS(); const pg8::Gemm g_{B.Y, B.Wo_t + (size_t)l * D * D, (int)T, D, D, 0, 0}; const pg8::LatentSliceOrder S_{NWG, (int)blockIdx.x, 0}; const pg8::EpiF32 E_{B.YO, D, in.b_out + l * D};
            pg8::gemm_phase<pg8::EpiF32, pg8::LatentSliceOrder, false>(lds + RING_OFF, g_, S_, E_); }
#else
        GEMM_PHASE(pg8::EpiF32, (B.YO, D, in.b_out + l * D), B.Y, B.Wo_t + (size_t)l * D * D, in.w_out + (size_t)l * D * D, (int)T, D, D, in.b_out + l * D, B.YO, (bf16_t*)nullptr, D);
#endif
        GRID_SYNC();
        DUP_END
        DUP_BEGIN(8)
        if (rep_ == 1) { RUN_ITEMS(NEXP, B.cnt[gi_ * CNT_STRIDE] = 0); GRID_SYNC(); }
        DBG_DUMP("YO", l, B.YO, T * D);
        {
            PHASE_ARGS();
            const int cap = (int)T * 2; const bool lastl = (l + 1 == dm.L);
            float* const Xp = B.X; const float* const MODc = B.MOD + (size_t)l * (NB + 1) * NMOD * D; (void)lastl;
#ifdef CPU_SHIM
            RUN_ITEMS(T, d_ln1_route(gi_, Xp, B.H, B.YO, MODc, in.ln1_g + l * D, in.ln1_b + l * D, ALPHA, B.Hb, in.w_group + (size_t)l * D * NGRP, in.b_group + l * NGRP,
                      in.w_router + (size_t)l * D * NEXP, in.b_router + l * NEXP, B.cnt, B.list, cap, B.tokinfo, B.tokgate, dm));
#else
            const int tl = ltid(); constexpr int NQ = Dims::T / 4, NREC = 4 * ((NQ + NWG * 8 - 1) / (NWG * 8));
            LAS int* lcnt = (LAS int*)(lds + MISC_OFF + 1024); LAS int* lbase = lcnt + 32; LAS int* recs = lcnt + 64;
            LAS float* wrl = (LAS float*)(lds + RING_OFF);
            __syncthreads();
            if (tl < 32) lcnt[tl] = 0;
            if (tl < 8 * NREC) recs[8 * tl] = -1;
            { const float* wsrc = in.w_router + (size_t)l * D * NEXP;
              static_assert(D * NGRP == 8 * 512, "8 (row, group) pairs per thread");
              f32x4 a[8], bq[8];
#pragma unroll
              for (int it = 0; it < 8; ++it) { const int i = tl + 512 * it, k = i >> 2, g = i & 3; a[it] = *(const f32x4*)(wsrc + (size_t)k * NEXP + g * EPG); bq[it] = *(const f32x4*)(wsrc + (size_t)k * NEXP + g * EPG + 4); }
              __builtin_amdgcn_sched_barrier(0);
#pragma unroll
              for (int it = 0; it < 8; ++it) { const int i = tl + 512 * it, k = i >> 2, g = i & 3, slot = (k & ~63) + 16 * (k & 3) + ((k & 63) >> 2);
                  LAS float* dp = wrl + (g * D + slot) * 4; *(LAS f32x4*)dp = a[it]; *(LAS f32x4*)(dp + NGRP * D * 4) = bq[it]; } }
            __syncthreads();
            static_assert(NQ == 2 * NWG * 8 + NWG / 2, "two quads per wave + 128 left over: those go to wave 0 of workgroups 0..127 (one per CU) instead of all eight waves of 16 workgroups");
            { for (int i = 0; i < 3; ++i) { const int qd = i < 2 ? (int)(blockIdx.x * 8 + (tl >> 6)) + i * NWG * 8 : ((tl >> 6) == 0 && (int)blockIdx.x < NWG / 2 ? 2 * NWG * 8 + (int)blockIdx.x : NQ);
                if (qd >= NQ) break;
                ln1_route_quad(4 * qd + ((tl & 63) >> 4), tl & 63, Xp, l == 0 ? in.x : (const float*)nullptr, in.ctx, B.H, B.YO, MODc, in.ln1_g + l * D, in.ln1_b + l * D, ALPHA, B.Hb, in.w_group + (size_t)l * D * NGRP, in.b_group + l * NGRP,
                               wrl, in.b_router + l * NEXP, lcnt, recs + 8 * ((tl >> 6) * NREC + 4 * i + ((tl & 63) >> 4)), B.tokgate); } }
            route_flush(tl, NREC, lcnt, lbase, recs, B.cnt, B.list, cap, B.tokinfo);
#endif
        }
        GRID_SYNC();
        DUP_END
        DUP_BEGIN(9)
        {
            PHASE_ARGS();
            const int cap = (int)T * 2; const size_t ws1 = (size_t)D * DEXP;
#ifdef CPU_SHIM
            d_moe_tst(B.cnt, B.tst);
            RUN_ITEMS((size_t)B.tst[NEXP] * 256 * DEXP, d_moe1_ref(gi_, B.Hb, in.w1 + (size_t)l * NEXP * ws1, in.w3 + (size_t)l * NEXP * ws1, B.cnt, B.tst, B.list, cap, B.HHb));
#else
            (void)ws1;
            LAS int* tst = (LAS int*)(lds + MISC_OFF + 64); LAS int* cntl = (LAS int*)(lds + MISC_OFF + 256);
            build_tst(B.cnt, tst, cntl);
            const pg8::MoeOrder S_{tst, cntl, B.list, cap, NWG, (int)blockIdx.x};
            const pg8::Gemm g_{B.Hb, B.W13_t, 0, 0, D}; const pg8::EpiSwiglu E_{B.HHb, DEXP};
            pg8::gemm_phase<pg8::EpiSwiglu, pg8::MoeOrder, true>(lds + RING_OFF, g_, S_, E_);
#endif
        }
        GRID_SYNC();
        DUP_END
        DUP_BEGIN(10)
        {
            PHASE_ARGS();
#ifdef CPU_SHIM
            RUN_ITEMS((size_t)B.tst[NEXP] * 256 * D, d_moe2_ref(gi_, B.HHb, in.w2 + (size_t)l * NEXP * D * DEXP, B.tst, B.Ob));
#else
            LAS int* tst = (LAS int*)(lds + MISC_OFF + 64); LAS int* cntl = (LAS int*)(lds + MISC_OFF + 256);
            const pg8::MoeOrder S_{tst, cntl, B.list, (int)T * 2, NWG, (int)blockIdx.x};
            const pg8::Gemm g_{B.HHb, B.W2_t, 0, 0, DEXP}; const pg8::EpiBf16 E_{B.Ob, D, nullptr, 3, 0};
            pg8::gemm_phase<pg8::EpiBf16, pg8::MoeOrder, false>(lds + RING_OFF, g_, S_, E_);
#endif
        }
        GRID_SYNC();
        DUP_END
        DUP_BEGIN(11)
        {
            PHASE_ARGS();
            const bool lastl = (l + 1 == dm.L);
            float* const Xp = B.X; const float* const MODc = B.MOD + (size_t)l * (NB + 1) * NMOD * D; const float* const MODn = lastl ? (const float*)nullptr : MODc + (size_t)(NB + 1) * NMOD * D;
#ifdef CPU_SHIM
            RUN_ITEMS(T, d_combine_ln2(gi_, B.H, Xp, B.Ob, B.tst, B.tokinfo, B.tokgate, MODc, MODn, in.ln2_g + l * D, in.ln2_b + l * D, ALPHA, B.Hb, out, dm));
#else
            const LAS int* tst = (const LAS int*)(lds + MISC_OFF + 64);
            const int tl = ltid();
            LAS float* vec = (LAS float*)(lds + RING_OFF);
            __syncthreads();
            { constexpr int NV = (2 * D + 3 * 3 * D) / 4;
              f32x4 vv[6];
#pragma unroll
              for (int it = 0; it < 6; ++it) { const int vi = tl + 512 * it < NV ? tl + 512 * it : 0; const float* sp;
                  if (vi < D / 4) sp = in.ln2_g + l * D + 4 * vi; else if (vi < D / 2) sp = in.ln2_b + l * D + 4 * (vi - D / 4);
                  else { const int w_ = vi - D / 2, r_ = w_ / (3 * D / 4), k4 = w_ % (3 * D / 4);
                      sp = k4 < D / 4 ? MODc + (size_t)r_ * NMOD * D + 5 * D + 4 * k4 : (MODn ? MODn : MODc) + (size_t)r_ * NMOD * D + 4 * (k4 - D / 4); }
                  vv[it] = *(const f32x4*)sp; }
              __builtin_amdgcn_sched_barrier(0);
#pragma unroll
              for (int it = 0; it < 6; ++it) if (tl + 512 * it < NV) *(LAS f32x4*)(vec + 4 * (tl + 512 * it)) = vv[it]; }
            __syncthreads();
            for (int i = 0; i < 3; ++i) { const int qd = i < 2 ? (int)(blockIdx.x * 8 + (tl >> 6)) + i * NWG * 8 : ((tl >> 6) == 0 && (int)blockIdx.x < NWG / 2 ? 2 * NWG * 8 + (int)blockIdx.x : Dims::T / 4);
                if (qd >= Dims::T / 4) break;
                combine_ln2_quad(4 * qd + ((tl & 63) >> 4), tl & 63, B.H, Xp, B.Ob, tst, B.tokinfo, B.tokgate, vec, MODn != nullptr, ALPHA, B.Hb, out); }
#endif
        }
        GRID_SYNC();
        DUP_END
        DBG_DUMP("X2", l, B.X, T * D);
    }
#if defined(PROBE_K1) && !defined(CPU_SHIM)
    GRID_SYNC();
    {
        PHASE_ARGS(); const unsigned long long* ts_ = (const unsigned long long*)(A_->ws + 32768);
        const double total = (double)(ts_[1 + 2 + 11 * Dims::L] - ts_[1]); double c1 = 0.0, c2 = 0.0;
        for (int k = 0; k < 2 + 11 * Dims::L; ++k) { const int cat = k < 2 ? 0 : 1 + (k - 2) % 11; const double d = (double)(ts_[2 + k] - ts_[1 + k]); if (cat == PROBE_K1) c1 += d; if (cat == PROBE_K2) c2 += d; }
        const size_t nz = (size_t)((c1 / total) * (double)(NB * Dims::S)) * D;
        RUN_ITEMS(nz, out[gi_] = 0.0f);
        if (blockIdx.x == 0 && threadIdx.x == 0) out[(size_t)NB * Dims::S * D - 1] = (float)(1000.0 * c2 / total);
    }
#endif
}

#ifndef CPU_SHIM
__global__ void __launch_bounds__(512, 2) mega_fwd(Args a) {
    extern __shared__ __attribute__((aligned(16))) unsigned char lds_raw[];
    LAS unsigned char* lds = (LAS unsigned char*)lds_raw;
    if (threadIdx.x < 4) ((LAS unsigned*)(lds + MISC_OFF))[threadIdx.x] = 0u;
    __syncthreads();
    const XcdBarrier bar = xcd_barrier_post((unsigned*)(a.ws + WS_CTL), (volatile LAS unsigned*)(lds + MISC_OFF));
    PROBE_STAMP();
    forward_program(a.dm, bar, lds);
}
#endif
}

extern "C" void kernel_launch(void* const* d_in, const int* in_sizes, int n_in, void* d_out, int out_size, void* d_ws, size_t ws_size, hipStream_t stream) {
    nv::Args a{};
    const float** f = (const float**)&a.in;
    for (int i = 0; i < 36; ++i) f[i] = (const float*)d_in[i];
    a.out = (float*)d_out; a.ws = (char*)d_ws;
#ifdef CPU_SHIM
    a.dm.S = in_sizes[0] / (nv::NB * nv::D);
    a.dm.L = in_sizes[5] / (nv::NMOD * nv::D);
    a.dm.TPB = nv::CTX + a.dm.S; a.dm.T = nv::NB * a.dm.TPB;
    a.dm.nslots = ((a.dm.T * 2 + 127) / 128 + nv::NEXP) * 128; a.dm.pad = 0;
#else
    if (in_sizes[0] != nv::NB * nv::Dims::S * nv::D || in_sizes[5] != nv::Dims::L * nv::NMOD * nv::D) return;
#endif
    a.B = nv::make_bufs(a.ws, a.dm);
    if (a.B.ws_end > ws_size) return;
#ifdef CPU_SHIM
    nv::forward_program(a.in, a.B, a.out, a.dm);
#else
    static int grid = 0;
    if (grid == 0) {
        int dev = 0, cus = 0; if (hipGetDevice(&dev) != hipSuccess || hipDeviceGetAttribute(&cus, hipDeviceAttributeMultiprocessorCount, dev) != hipSuccess || cus <= 0) cus = 256;
        (void)hipFuncSetAttribute((const void*)nv::mega_fwd, hipFuncAttributeMaxDynamicSharedMemorySize, nv::LDS_BYTES);
        (void)hipGetLastError();
        grid = nv::NWG; (void)cus;
    }
    (void)hipMemsetAsync((char*)d_ws + nv::WS_CTL, 0, nv::CTL_BYTES, stream);
    hipLaunchKernelGGL(nv::mega_fwd, dim3(grid), dim3(512), nv::LDS_BYTES, stream, a);
#endif
}
```

```cpp
#ifndef CPU_SHIM
#include <hip/hip_runtime.h>
#endif
#include <stdint.h>
#include <stddef.h>
#include <math.h>
#include <string.h>

#ifndef DBG_DUMP
#define DBG_DUMP(name, l, ptr, n)
#endif

#ifndef CPU_SHIM
#define XB_TMO      128
#define XB_XCNT(j)  (256  + 64 * (j))
#define XB_XSUB(j)  (1280 + 64 * (j))
#define XB_XGEN(j)  (2304 + 64 * (j))
#define XB_TOP      3328
#define XB_TOPGEN   3392
#define XCD_BAR_WORDS 3456
#define XB_SPIN_CAP (1u << 18)
#define LAS __attribute__((address_space(3)))

__device__ __forceinline__ unsigned xb_ld(unsigned* p)              { return __hip_atomic_load(p, __ATOMIC_RELAXED, __HIP_MEMORY_SCOPE_AGENT); }
__device__ __forceinline__ unsigned xb_add(unsigned* p, unsigned v) { return __hip_atomic_fetch_add(p, v, __ATOMIC_RELAXED, __HIP_MEMORY_SCOPE_AGENT); }
__device__ __forceinline__ unsigned xb_xcc_id() { return (unsigned)__builtin_amdgcn_s_getreg((3 << 11) | 20) & 0xFu; }
#define XB_SPIN(cond, bar) do { unsigned _sp = 0; while (cond) { __builtin_amdgcn_s_sleep(1); \
    if ((++_sp & 255u) == 0u) { if (xb_ld(&(bar)[XB_TMO])) break; if (_sp > XB_SPIN_CAP) { atomicAdd(&(bar)[XB_TMO], 1u); break; } } } } while (0)

struct XcdBarrier { unsigned* bar; unsigned x; volatile LAS unsigned* st; };

__device__ __forceinline__ XcdBarrier xcd_barrier_post(unsigned* bar, volatile LAS unsigned* st) {
    XcdBarrier b; b.bar = bar; b.x = xb_xcc_id(); b.st = st;
    if (threadIdx.x == 0) (void)xb_add(&bar[XB_XCNT(b.x)], 1u);
    return b;
}
__device__ __forceinline__ void xcd_barrier_complete(unsigned* bar, unsigned x, unsigned& nloc, unsigned& nx) {
    const unsigned G = gridDim.x * gridDim.y * gridDim.z;
    unsigned sum, cnt, mine, sp = 0u;
    for (;;) {
        sum = 0u; cnt = 0u; mine = 0u;
#pragma unroll
        for (unsigned j = 0; j < 16; ++j) { const unsigned c = xb_ld(&bar[XB_XCNT(j)]); sum += c; cnt += (c > 0u) ? 1u : 0u; mine = (j == x) ? c : mine; }
        if (sum == G) break;
        __builtin_amdgcn_s_sleep(1);
        if ((++sp & 255u) == 0u) { if (xb_ld(&bar[XB_TMO])) break; if (sp > XB_SPIN_CAP) { atomicAdd(&bar[XB_TMO], 1u); break; } }
    }
    nloc = mine > 0u ? mine : 1u; nx = cnt > 0u ? cnt : 1u;
}
__device__ __forceinline__ void xcd_barrier(const XcdBarrier& b) {
    asm volatile("s_waitcnt vmcnt(0)" ::: "memory");
    __syncthreads();
    if (threadIdx.x == 0) {
        unsigned* bar = b.bar;
        __builtin_amdgcn_s_waitcnt(0);
        unsigned nloc = b.st[0], nx = b.st[1];
        if (nloc == 0u) { xcd_barrier_complete(bar, b.x, nloc, nx); b.st[0] = nloc; b.st[1] = nx; }
        const unsigned old = xb_add(&bar[XB_XSUB(b.x)], 1u);
        const unsigned gen = old / nloc;
        if (old + 1u == (gen + 1u) * nloc) {
            __builtin_amdgcn_fence(__ATOMIC_RELEASE, "agent");
            asm volatile("s_waitcnt vmcnt(0)" ::: "memory");
            const unsigned og = xb_add(&bar[XB_TOP], 1u);
            const unsigned tg = og / nx;
            if (og + 1u == (tg + 1u) * nx) xb_add(&bar[XB_TOPGEN], 1u);
            else XB_SPIN(xb_ld(&bar[XB_TOPGEN]) == tg, bar);
            __builtin_amdgcn_fence(__ATOMIC_ACQUIRE, "agent");
            xb_add(&bar[XB_XGEN(b.x)], 1u);
            asm volatile("s_waitcnt vmcnt(0)" ::: "memory");
        } else {
            XB_SPIN(xb_ld(&bar[XB_XGEN(b.x)]) == gen, bar);
            __builtin_amdgcn_fence(__ATOMIC_ACQUIRE, "agent");
            asm volatile("s_waitcnt vmcnt(0)" ::: "memory");
        }
    }
    __syncthreads();
}
#endif

#ifndef CPU_SHIM
namespace pg8 {
#define PG8_LAS __attribute__((address_space(3)))
typedef unsigned short bf16_t;
typedef short bf16x8 __attribute__((ext_vector_type(8)));
typedef float f32x4 __attribute__((ext_vector_type(4)));
typedef float f32x2 __attribute__((ext_vector_type(2)));
typedef unsigned u32x4 __attribute__((ext_vector_type(4)));
typedef unsigned u32x2 __attribute__((ext_vector_type(2)));
constexpr int BM = 256, BK = 64, HALF = 128, HTB = HALF * BK * 2  , STAGE_BYTES = 8 * HTB, NXCD = 8, WGM = 8;

__host__ __device__ __forceinline__ int lds_byte(int r, int c) { const int st = (r >> 4) * 2 + (c >> 5), rr = r & 15, cc = c & 31, ob = rr * 64 + cc * 2; return st * 1024 + (ob ^ (((ob >> 9) & 1) << 5)); }
__host__ __device__ __forceinline__ void stage_rc(int b, int& R, int& C) { const int st = b / 1024, sb = b % 1024, swz = sb ^ (((sb >> 9) & 1) << 5); R = (st >> 1) * 16 + swz / 64; C = (st & 1) * 32 + (swz % 64) / 2; }
__host__ __device__ __forceinline__ int perm32(int rho) { const int n = rho >> 4, i = rho & 15; return 8 * (i >> 2) + 4 * n + (i & 3); }

template <class T, class... A> __device__ __forceinline__ T mk(A... a) { return T{a...}; }
struct Unit { int pm, pn, e, valid, ks; };
struct Gemm { const bf16_t* A; const bf16_t* Bt; int M, N, K, lda, ldb; };

struct StaticOrder {
    int nM, nN, nwg, G, c;
    __host__ __device__ void init(int M, int N, int G_, int c_) { nM = M / BM; nN = N / BM; nwg = nM * nN; G = G_; c = c_; }
    __host__ __device__ bool next(int i, Unit& u) const {
        const long L = (long)i * G + c; if (L >= nwg) return false;
        int wgid = (int)L; { const int q = nwg / NXCD, r = nwg % NXCD, xcd = wgid % NXCD, off = wgid / NXCD; wgid = (xcd < r ? xcd * (q + 1) : r * (q + 1) + (xcd - r) * q) + off; }
        const int nig = WGM * nN, gid = wgid / nig, fm = gid * WGM, gsz = (nM - fm) < WGM ? (nM - fm) : WGM;
        u.pm = fm + ((wgid % nig) % gsz); u.pn = (wgid % nig) / gsz; u.ks = 0; return true;
    }
    __device__ __forceinline__ void a_ready(const Unit&) const {}
    __device__ __forceinline__ void done(const Unit&) const {}
};
typedef __bf16 bf16x2n __attribute__((ext_vector_type(2)));
__device__ __forceinline__ unsigned cvt_pk_bf16(float lo, float hi) { const f32x2 v = {lo, hi}; return __builtin_bit_cast(unsigned, __builtin_convertvector(v, bf16x2n)); }

struct EpiF32 {
    static constexpr bool PERM = false, AFTER_DRAIN = false, LDS_AUX = false;
    float* C; int ldc; const float* bias;
    __device__ __forceinline__ void operator()(const f32x4 (&acc)[2][2][4][2], const Unit& u, int wr, int wc, int fr, int fq) const {
        const int row0 = u.pm * BM + wr * 64 + fr, col0 = u.pn * BM + wc * 32 + 4 * fq;
        f32x4 bv[2][2];
#pragma unroll
        for (int bj = 0; bj < 2; ++bj)
#pragma unroll
            for (int n = 0; n < 2; ++n) bv[bj][n] = bias ? *(const f32x4*)(bias + col0 + bj * HALF + n * 16) : (f32x4){0.f, 0.f, 0.f, 0.f};
#pragma unroll
        for (int ai = 0; ai < 2; ++ai)
#pragma unroll
            for (int m = 0; m < 4; ++m) { float* rowp = C + (size_t)(row0 + ai * HALF + m * 16) * ldc + col0;
#pragma unroll
                for (int bj = 0; bj < 2; ++bj)
#pragma unroll
                    for (int n = 0; n < 2; ++n) *(f32x4*)(rowp + bj * HALF + n * 16) = acc[ai][bj][m][n] + bv[bj][n]; }
    }
};
struct EpiBf16 {
    static constexpr bool PERM = true, AFTER_DRAIN = false, LDS_AUX = false;
    bf16_t* O0; int ldc; const float* bias; int pnmask; size_t ks_stride;
    __device__ __forceinline__ void operator()(const f32x4 (&acc)[2][2][4][2], const Unit& u, int wr, int wc, int fr, int fq) const {
        bf16_t* const O = O0 + (size_t)u.ks * ks_stride;
        const int row0 = u.pm * BM + wr * 64 + fr, col0 = (u.pn & pnmask) * BM + wc * 32 + 8 * fq;
        f32x4 bv[2][2];
#pragma unroll
        for (int bj = 0; bj < 2; ++bj)
#pragma unroll
            for (int n = 0; n < 2; ++n) bv[bj][n] = bias ? *(const f32x4*)(bias + col0 + bj * HALF + 4 * n) : (f32x4){0.f, 0.f, 0.f, 0.f};
#pragma unroll
        for (int ai = 0; ai < 2; ++ai)
#pragma unroll
            for (int m = 0; m < 4; ++m) { bf16_t* rowp = O + (size_t)(row0 + ai * HALF + m * 16) * ldc + col0;
#pragma unroll
                for (int bj = 0; bj < 2; ++bj) { const f32x4 v0 = acc[ai][bj][m][0] + bv[bj][0], v1 = acc[ai][bj][m][1] + bv[bj][1];
                    u32x4 w; w.x = cvt_pk_bf16(v0[0], v0[1]); w.y = cvt_pk_bf16(v0[2], v0[3]); w.z = cvt_pk_bf16(v1[0], v1[1]); w.w = cvt_pk_bf16(v1[2], v1[3]);
                    *(u32x4*)(rowp + bj * HALF) = w; } }
    }
};

template <int MODE> struct EpiMerge {
    static constexpr bool PERM = true, AFTER_DRAIN = false, LDS_AUX = false;
    const bf16_t* G; int ldg, goff; float* Yacc; bf16_t* Y; int ldy;
    __device__ __forceinline__ void operator()(const f32x4 (&acc)[2][2][4][2], const Unit& u, int wr, int wc, int fr, int fq) const {
        const int row0 = u.pm * BM + wr * 64 + fr, col0 = u.pn * BM + wc * 32 + 8 * fq;
#pragma unroll
        for (int ai = 0; ai < 2; ++ai)
#pragma unroll
            for (int m = 0; m < 4; ++m) { const size_t row = (size_t)(row0 + ai * HALF + m * 16);
#pragma unroll
                for (int bj = 0; bj < 2; ++bj) { const int col = col0 + bj * HALF;
                    const u32x4 gw = *(const u32x4*)(G + row * ldg + goff + col);
                    f32x4 g0, g1; g0.x = __uint_as_float(gw.x << 16); g0.y = __uint_as_float(gw.x & 0xffff0000u); g0.z = __uint_as_float(gw.y << 16); g0.w = __uint_as_float(gw.y & 0xffff0000u);
                    g1.x = __uint_as_float(gw.z << 16); g1.y = __uint_as_float(gw.z & 0xffff0000u); g1.z = __uint_as_float(gw.w << 16); g1.w = __uint_as_float(gw.w & 0xffff0000u);
                    f32x4 v0 = g0 * acc[ai][bj][m][0], v1 = g1 * acc[ai][bj][m][1];
                    float* yp = Yacc + row * ldy + col;
                    if (MODE >= 1) { v0 += *(const f32x4*)yp; v1 += *(const f32x4*)(yp + 4); }
                    if (MODE <= 1) { *(f32x4*)yp = v0; *(f32x4*)(yp + 4) = v1; }
                    else { u32x4 w; w.x = cvt_pk_bf16(v0[0], v0[1]); w.y = cvt_pk_bf16(v0[2], v0[3]); w.z = cvt_pk_bf16(v1[0], v1[1]); w.w = cvt_pk_bf16(v1[2], v1[3]); *(u32x4*)(Y + row * ldy + col) = w; } } }
    }
};
struct SliceOrder {
    StaticOrder T4; int G, c;
    __device__ __forceinline__ bool next(int i, Unit& u) const { const int L = i * G + c; StaticOrder one = T4; one.G = 1; one.c = 0; if (!one.next(L >> 2, u)) return false; u.ks = L & 3; return true; }
    __device__ __forceinline__ void a_ready(const Unit&) const {}
    __device__ __forceinline__ void done(const Unit&) const {}
};
struct LatentSliceOrder {
    int G, c, lg;
    __device__ __forceinline__ bool next(int i, Unit& u) const { const int L = lg == 0 ? ((c & 7) * (G >> 3) + (c >> 3) + G * i) : i * G + c, tile = L >> lg; if (tile >= 256) return false; const int pmL = tile >> 2;
        u.pm = pmL + 1 + (pmL >= 32 ? 1 : 0); u.pn = tile & 3; u.ks = L & ((1 << lg) - 1); return true; }
    __device__ __forceinline__ void a_ready(const Unit&) const {}
    __device__ __forceinline__ void done(const Unit&) const {}
};
struct OneTileOrder {
    int pm, pn;
    __device__ __forceinline__ bool next(int i, Unit& u) const { if (i > 0) return false; u.pm = pm; u.pn = pn; u.ks = 0; return true; }
    __device__ __forceinline__ void a_ready(const Unit&) const {}
    __device__ __forceinline__ void done(const Unit&) const {}
};
struct EpiSwiglu {
    static constexpr bool PERM = true, AFTER_DRAIN = false, LDS_AUX = false;
    bf16_t* HH; int ldc;
    __device__ __forceinline__ void operator()(const f32x4 (&acc)[2][2][4][2], const Unit& u, int wr, int wc, int fr, int fq) const {
        const int row0 = u.pm * BM + wr * 64 + fr, col0 = (u.pn & 3) * HALF + wc * 32 + 8 * fq;
#pragma unroll
        for (int ai = 0; ai < 2; ++ai)
#pragma unroll
            for (int m = 0; m < 4; ++m) { float h[8];
#pragma unroll
                for (int n = 0; n < 2; ++n)
#pragma unroll
                    for (int j = 0; j < 4; ++j) { const float a = acc[ai][0][m][n][j], b = acc[ai][1][m][n][j]; h[4 * n + j] = a * __builtin_amdgcn_rcpf(1.0f + __expf(-a)) * b; }
                u32x4 w; w.x = cvt_pk_bf16(h[0], h[1]); w.y = cvt_pk_bf16(h[2], h[3]); w.z = cvt_pk_bf16(h[4], h[5]); w.w = cvt_pk_bf16(h[6], h[7]);
                *(u32x4*)(HH + (size_t)(row0 + ai * HALF + m * 16) * ldc + col0) = w; }
    }
};
struct MoeOrder {
    const PG8_LAS int* tst; const PG8_LAS int* cntl; const int* list; int cap, G, c;
    __device__ __forceinline__ bool next(int i, Unit& u) const {
        const int ntile = __builtin_amdgcn_readfirstlane(tst[32]); const int U = 4 * ntile, x = c & 7, lo = (x * U) >> 3, hi = ((x + 1) * U) >> 3;
        const int L = lo + (c >> 3) + (G >> 3) * i, q = L >> 2;
        if (L >= hi) return false;
        int e = 0;
        for (int k = 1; k < 32; ++k) e += (__builtin_amdgcn_readfirstlane(tst[k]) <= q) ? 1 : 0;
        const int r = q - __builtin_amdgcn_readfirstlane(tst[e]); const int left = __builtin_amdgcn_readfirstlane(cntl[e]) - 256 * r;
        u.pm = q; u.pn = 4 * e + (L & 3); u.e = e * cap + 256 * r; u.valid = left < 256 ? left : 256; u.ks = 0; return true;
    }
    __device__ __forceinline__ int row_tok(const Unit& u, int rr) const { return rr < u.valid ? list[u.e + rr] : 0; }
    __device__ __forceinline__ void a_ready(const Unit&) const {}
    __device__ __forceinline__ void done(const Unit&) const {}
};

template <class Epi, class Sched, bool GATHER = false>
__device__ __forceinline__ void gemm_phase(PG8_LAS unsigned char* lds, const Gemm g, const Sched& S, const Epi& E) {
    int tid_ = threadIdx.x; asm volatile("" : "+v"(tid_));
    const int tid = tid_, wid = __builtin_amdgcn_readfirstlane(tid >> 6), lane = tid & 63, wr = wid >> 2, wc = wid & 3, fr = lane & 15, fq = lane >> 4;
    const int K = g.K, nt = K / BK, lda = g.lda ? g.lda : K, ldb = g.ldb ? g.ldb : K;
    unsigned voffA[2], voffB[2];
#pragma unroll
    for (int i = 0; i < 2; ++i) { int R, C; stage_rc(tid * 16 + i * 8192, R, C); const int Rb = Epi::PERM ? ((R & ~31) + perm32(R & 31)) : R;
        voffA[i] = (unsigned)(R * lda + C) * 2u; voffB[i] = (unsigned)(Rb * ldb + C) * 2u; }
    const size_t kstep = (size_t)(BK * 2);
    const size_t hstepA = (size_t)HALF * lda * 2, hstepB = (size_t)HALF * ldb * 2;
    const size_t tstepA = 2 * hstepA, tstepB = 2 * hstepB, sstep = (size_t)K * 2;
    const unsigned ldsw = (unsigned)wid * 1024u;
    const int aoff = lds_byte(wr * 64 + fr, fq * 8), boff = lds_byte(wc * 32 + fr, fq * 8);
    int R0g, C0g; stage_rc(tid * 16, R0g, C0g);
    const char* const gA = (const char*)g.A;
    unsigned va_c[4] = {0u, 0u, 0u, 0u}, va_n[4] = {0u, 0u, 0u, 0u};
#define PG8_LOADIDX(dst, unit) do { _Pragma("unroll") for (int q_ = 0; q_ < 4; ++q_) dst[q_] = (unsigned)S.row_tok(unit, (q_ >> 1) * 128 + R0g + (q_ & 1) * 64) * (unsigned)(lda * 2) + (unsigned)(C0g * 2); } while (0)
#define PG8_STAGE_G(bufoff, kbytes, v0, v1) do { \
        __builtin_amdgcn_global_load_lds((const unsigned*)(gA + (kbytes) + (v0)), (PG8_LAS unsigned*)(lds + (bufoff) + ldsw), 16, 0, 0); \
        __builtin_amdgcn_global_load_lds((const unsigned*)(gA + (kbytes) + (v1)), (PG8_LAS unsigned*)(lds + (bufoff) + ldsw + 8192), 16, 0, 0); } while (0)
#define PG8_SA(b, h) (((b) * 2 + (h)) * HTB)
#define PG8_SB(b, h) ((4 + (b) * 2 + (h)) * HTB)
#define PG8_STAGE(bufoff, gbase, voff) do { _Pragma("unroll") for (int _i = 0; _i < 2; ++_i) \
        __builtin_amdgcn_global_load_lds((const unsigned*)((const char*)(gbase) + (voff)[_i]), (PG8_LAS unsigned*)(lds + (bufoff) + ldsw + _i * 8192), 16, 0, 0); } while (0)
#define PG8_LDA(dst, b, h) do { _Pragma("unroll") for (int m = 0; m < 4; ++m) _Pragma("unroll") for (int k = 0; k < 2; ++k) dst[m][k] = *(const PG8_LAS bf16x8*)(lds + PG8_SA(b, h) + aoff + m * 2048 + k * 1024); } while (0)
#define PG8_LDB(dst, b, h) do { _Pragma("unroll") for (int n = 0; n < 2; ++n) _Pragma("unroll") for (int k = 0; k < 2; ++k) dst[n][k] = *(const PG8_LAS bf16x8*)(lds + PG8_SB(b, h) + boff + n * 2048 + k * 1024); } while (0)
#define PG8_MMA(ai, bj, At, Bt) do { __builtin_amdgcn_s_setprio(1); _Pragma("unroll") for (int m = 0; m < 4; ++m) _Pragma("unroll") for (int n = 0; n < 2; ++n) _Pragma("unroll") for (int k = 0; k < 2; ++k) \
        acc[ai][bj][m][n] = __builtin_amdgcn_mfma_f32_16x16x32_bf16(Bt[n][k], At[m][k], acc[ai][bj][m][n], 0, 0, 0); __builtin_amdgcn_s_setprio(0); } while (0)
#define PG8_WAIT_V(n) asm volatile("s_waitcnt vmcnt(" #n ")" ::: "memory")
#define PG8_WAIT_L(n) asm volatile("s_waitcnt lgkmcnt(" #n ")" ::: "memory")
#define PG8_BAR __builtin_amdgcn_s_barrier()
#define PG8_SCHED __builtin_amdgcn_sched_barrier(0)
    Unit cur, nxt; int ui = 0;
    if (!S.next(0, cur)) return;
    f32x4 acc[2][2][4][2];
#pragma unroll
    for (int a = 0; a < 2; ++a)
#pragma unroll
        for (int b = 0; b < 2; ++b)
#pragma unroll
            for (int m = 0; m < 4; ++m)
#pragma unroll
                for (int n = 0; n < 2; ++n) acc[a][b][m][n] = (f32x4){0.f, 0.f, 0.f, 0.f};
    bf16x8 At[4][2], B0[2][2], B1[2][2];
    const char* cA = (const char*)g.A + (size_t)cur.pm * tstepA + (size_t)cur.ks * sstep; const char* cB = (const char*)g.Bt + (size_t)cur.pn * tstepB + (size_t)cur.ks * sstep;
    S.a_ready(cur);
    if constexpr (Epi::LDS_AUX) E.aux_dma(cur, 0, lane);
    bool has_next = S.next(1, nxt);
    if constexpr (GATHER) { PG8_LOADIDX(va_c, cur); if (has_next) PG8_LOADIDX(va_n, nxt); else { _Pragma("unroll") for (int q_ = 0; q_ < 4; ++q_) va_n[q_] = va_c[q_]; } }
    PG8_STAGE(PG8_SB(0, 0), cB, voffB);
    if constexpr (GATHER) PG8_STAGE_G(PG8_SA(0, 0), (size_t)0, va_c[0], va_c[1]); else PG8_STAGE(PG8_SA(0, 0), cA, voffA);
    PG8_STAGE(PG8_SB(0, 1), cB + hstepB, voffB);
    if constexpr (GATHER) PG8_STAGE_G(PG8_SA(0, 1), (size_t)0, va_c[2], va_c[3]); else PG8_STAGE(PG8_SA(0, 1), cA + hstepA, voffA);
    if (wr == 1) PG8_BAR;
    PG8_WAIT_V(4); PG8_BAR;
    PG8_STAGE(PG8_SB(1, 0), cB + kstep, voffB);
    if constexpr (GATHER) PG8_STAGE_G(PG8_SA(1, 0), kstep, va_c[0], va_c[1]); else PG8_STAGE(PG8_SA(1, 0), cA + kstep, voffA);
    PG8_STAGE(PG8_SB(1, 1), cB + hstepB + kstep, voffB);
    PG8_WAIT_V(6); PG8_BAR;
    for (;;) {
        const char* nA = has_next ? (const char*)g.A + (size_t)nxt.pm * tstepA + (size_t)nxt.ks * sstep : cA; const char* nB = has_next ? (const char*)g.Bt + (size_t)nxt.pn * tstepB + (size_t)nxt.ks * sstep : cB;
        for (int t = 0; t < nt; t += 2) {
            const bool last = (t == nt - 2);
            const char* a1 = cA + (size_t)(t + 1) * kstep;
            const char* a2 = last ? nA : cA + (size_t)(t + 2) * kstep; const char* b2 = last ? nB : cB + (size_t)(t + 2) * kstep;
            const char* a3 = a2 + kstep; const char* b3 = b2 + kstep;
            if (last && has_next) { S.a_ready(nxt); if constexpr (Epi::LDS_AUX) E.aux_dma(nxt, (ui + 1) & 1, lane); }
            const size_t k1 = (size_t)(t + 1) * kstep, k2 = last ? (size_t)0 : (size_t)(t + 2) * kstep, k3 = k2 + kstep;
            unsigned vs[4];
            if constexpr (GATHER) { _Pragma("unroll") for (int q_ = 0; q_ < 4; ++q_) vs[q_] = last ? va_n[q_] : va_c[q_]; }
            PG8_LDB(B0, 0, 0); PG8_SCHED; PG8_LDA(At, 0, 0); if constexpr (GATHER) PG8_STAGE_G(PG8_SA(1, 1), k1, va_c[2], va_c[3]); else PG8_STAGE(PG8_SA(1, 1), a1 + hstepA, voffA);
            PG8_WAIT_L(8); PG8_BAR; PG8_WAIT_L(0); PG8_MMA(0, 0, At, B0); PG8_BAR; PG8_SCHED;
            PG8_LDB(B1, 0, 1); PG8_STAGE(PG8_SB(0, 0), b2, voffB);
            PG8_BAR; PG8_WAIT_L(0); PG8_MMA(0, 1, At, B1); PG8_BAR;
            PG8_LDA(At, 0, 1); if constexpr (GATHER) PG8_STAGE_G(PG8_SA(0, 0), k2, vs[0], vs[1]); else PG8_STAGE(PG8_SA(0, 0), a2, voffA);
            PG8_BAR; PG8_WAIT_L(0); PG8_MMA(1, 0, At, B0); PG8_BAR; PG8_SCHED;
            PG8_STAGE(PG8_SB(0, 1), b2 + hstepB, voffB);
            PG8_WAIT_V(6); PG8_BAR; PG8_MMA(1, 1, At, B1); PG8_BAR;
            PG8_LDB(B0, 1, 0); PG8_SCHED; PG8_LDA(At, 1, 0); if constexpr (GATHER) PG8_STAGE_G(PG8_SA(0, 1), k2, vs[2], vs[3]); else PG8_STAGE(PG8_SA(0, 1), a2 + hstepA, voffA);
            PG8_WAIT_L(8); PG8_BAR; PG8_WAIT_L(0); PG8_MMA(0, 0, At, B0); PG8_BAR; PG8_SCHED;
            PG8_LDB(B1, 1, 1); PG8_STAGE(PG8_SB(1, 0), b3, voffB);
            PG8_BAR; PG8_WAIT_L(0); PG8_MMA(0, 1, At, B1); PG8_BAR;
            PG8_LDA(At, 1, 1); if constexpr (GATHER) PG8_STAGE_G(PG8_SA(1, 0), k3, vs[0], vs[1]); else PG8_STAGE(PG8_SA(1, 0), a3, voffA);
            PG8_BAR; PG8_WAIT_L(0); PG8_MMA(1, 0, At, B0); PG8_BAR; PG8_SCHED;
            PG8_STAGE(PG8_SB(1, 1), b3 + hstepB, voffB);
            PG8_WAIT_V(6); PG8_BAR; PG8_MMA(1, 1, At, B1); PG8_BAR;
        }
        if constexpr (Epi::LDS_AUX) { E(acc, cur, wr, wc, fr, fq, ui & 1); S.done(cur); }
        else if constexpr (!Epi::AFTER_DRAIN) { E(acc, cur, wr, wc, fr, fq); S.done(cur); }
        if (!has_next) break;
#pragma unroll
        for (int a = 0; a < 2; ++a)
#pragma unroll
            for (int b = 0; b < 2; ++b)
#pragma unroll
                for (int m = 0; m < 4; ++m)
#pragma unroll
                    for (int n = 0; n < 2; ++n) acc[a][b][m][n] = (f32x4){0.f, 0.f, 0.f, 0.f};
        cur = nxt; cA = nA; cB = nB; ++ui;
        has_next = S.next(ui + 1, nxt);
        if constexpr (GATHER) { _Pragma("unroll") for (int q_ = 0; q_ < 4; ++q_) va_c[q_] = va_n[q_]; if (has_next) PG8_LOADIDX(va_n, nxt); }
    }
    PG8_WAIT_V(0);
    if (wr == 0) PG8_BAR;
    PG8_BAR;
    if constexpr (Epi::AFTER_DRAIN) { E.fused(acc, cur, wr, wc, fr, fq, lds, wid, lane); S.done(cur); }
#undef PG8_SA
#undef PG8_SB
#undef PG8_STAGE
#undef PG8_STAGE_G
#undef PG8_LOADIDX
#undef PG8_LDA
#undef PG8_LDB
#undef PG8_MMA
#undef PG8_WAIT_V
#undef PG8_WAIT_L
#undef PG8_BAR
#undef PG8_SCHED
}
}
#endif

namespace nv {
constexpr int D = 1024, NB = 2, CTX = 256, HD = 64, NH = 8, NKV = 2, ATT_W = 512, KV_W = 128, WIN = 128, CHUNK = 128;
constexpr int SGU_W = 512, SGU_GW = 128, LRU_W = 1024, LRU_BW = 128, NEXP = 32, EPG = 8, NGRP = 4, DEXP = 512, NMOD = 6;
constexpr int IN_W = 6912;
constexpr int OFF_Q = 0, OFF_U = 512, OFF_V = 1024, OFF_G = 1536, OFF_Z = 4608, OFF_K = 5632, OFF_VAL = 5760, OFF_XR = 5888;
constexpr float LN_EPS = 1e-6f;
constexpr int ABR_LD = 2 * D;
constexpr int CNT_STRIDE = 64;

#ifdef CPU_SHIM
struct Dims { int S, L, TPB, T, nslots, pad; };
#else
struct Dims { static constexpr int S = 8192, L = 4, TPB = CTX + S, T = NB * TPB, nslots = ((T * 2 + 127) / 128 + NEXP) * 128; int pad0, pad1; };
#endif

__device__ __forceinline__ float sigmoidf_(float x) { return 1.0f / (1.0f + expf(-x)); }
__device__ __forceinline__ float siluf_(float x) { return x / (1.0f + expf(-x)); }
__device__ __forceinline__ float geluf_(float x) { return 0.5f * x * (1.0f + tanhf(0.7978845608028654f * (x + 0.044715f * x * x * x))); }

typedef unsigned short bf16_t;
#ifdef CPU_SHIM
__host__ __device__ __forceinline__ bf16_t f2bf(float f) { unsigned u; memcpy(&u, &f, 4); u += 0x7fffu + ((u >> 16) & 1u); return (bf16_t)(u >> 16); }
#else
__device__ __forceinline__ unsigned cvt_pk_bf16(float lo, float hi) { return pg8::cvt_pk_bf16(lo, hi); }
__device__ __forceinline__ bf16_t f2bf(float f) { return (bf16_t)(cvt_pk_bf16(f, f) & 0xffffu); }
#endif
__host__ __device__ __forceinline__ float bf2f(bf16_t b) { unsigned u = ((unsigned)b) << 16; float f; memcpy(&f, &u, 4); return f; }

__device__ __forceinline__ void d_mod(size_t i, const float* c, const float* c_ctx, const float* w_mod, const float* b_mod, float* MOD, const Dims& dm) {
    const int l = (int)(i / (NMOD * D)), j = (int)(i % (NMOD * D));
    float a0 = 0.f, a1 = 0.f, a2 = 0.f;
    const float* w = w_mod + (size_t)l * D * NMOD * D + j;
    for (int k = 0; k < D; ++k) { const float wv = w[(size_t)k * NMOD * D]; a0 += siluf_(c[k]) * wv; a1 += siluf_(c[D + k]) * wv; a2 += siluf_(c_ctx[k]) * wv; }
    const float b = b_mod[(size_t)l * NMOD * D + j];
    float* m = MOD + (size_t)l * (NB + 1) * NMOD * D;
    m[j] = a0 + b; m[NMOD * D + j] = a1 + b; m[2 * NMOD * D + j] = a2 + b;
}
__device__ __forceinline__ void d_init_x(size_t i, const float* x, const float* ctx, float* X, const Dims& dm) {
    const int t = (int)(i / D), d = (int)(i % D), b = t / dm.TPB, p = t % dm.TPB;
    X[i] = p < CTX ? ctx[((size_t)b * CTX + p) * D + d] : x[((size_t)b * dm.S + (p - CTX)) * D + d];
}
__device__ __forceinline__ void d_write_out(size_t i, const float* X, float* out, const Dims& dm) {
    const int r = (int)(i / D), d = (int)(i % D), b = r / dm.S, s = r % dm.S;
    out[i] = X[((size_t)b * dm.TPB + CTX + s) * D + d];
}
__device__ __forceinline__ void d_modulate(size_t i, const float* X, const float* MODl, float* H, int shift, const Dims& dm) {
    const int t = (int)(i / D), d = (int)(i % D), b = t / dm.TPB, p = t % dm.TPB, row = p < CTX ? NB : b;
    const float* m = MODl + (size_t)row * NMOD * D;
    H[i] = X[i] * (1.0f + m[(shift + 1) * D + d]) + m[shift * D + d];
}
__device__ __forceinline__ void d_modulate_bf(size_t i, const float* X, const float* MODl, bf16_t* H, int shift, const Dims& dm) {
    const int t = (int)(i / D), d = (int)(i % D), b = t / dm.TPB, p = t % dm.TPB, row = p < CTX ? NB : b;
    const float* m = MODl + (size_t)row * NMOD * D;
    H[i] = f2bf(X[i] * (1.0f + m[(shift + 1) * D + d]) + m[shift * D + d]);
}
__device__ __forceinline__ void d_gemm_ref(size_t i, const bf16_t* A, int lda, const float* W, int ldb, const float* bias, float* Cf, bf16_t* Cb, int ldc, int N, int K) {
    const size_t m = i / N; const int n = (int)(i % N); float acc = 0.f;
    for (int k = 0; k < K; ++k) acc += bf2f(A[m * lda + k]) * bf2f(f2bf(W[(size_t)k * ldb + n]));
    if (bias) acc += bias[n];
    if (Cf) Cf[m * ldc + n] = acc; else Cb[m * ldc + n] = f2bf(acc);
}
__device__ __forceinline__ void d_gemm(size_t tid, const float* A, int lda, const int* arow, const float* Bm, int ldb, size_t bstride, const int* blk_e,
                                       const float* bias, float* C, int ldc, int M, int N, int K) {
    const int n4c = N / 4;
    const int n0 = (int)(tid % n4c) * 4, m0 = (int)(tid / n4c) * 4;
    const float* Bp = Bm + (blk_e ? (size_t)blk_e[m0 / 128] * bstride : (size_t)0) + n0;
    int r0 = m0, r1 = m0 + 1, r2 = m0 + 2, r3 = m0 + 3;
    if (arow) { r0 = arow[r0]; r1 = arow[r1]; r2 = arow[r2]; r3 = arow[r3]; }
    const float* a0 = A + (size_t)(r0 < 0 ? 0 : r0) * lda; const float* a1 = A + (size_t)(r1 < 0 ? 0 : r1) * lda;
    const float* a2 = A + (size_t)(r2 < 0 ? 0 : r2) * lda; const float* a3 = A + (size_t)(r3 < 0 ? 0 : r3) * lda;
    const float z0 = r0 < 0 ? 0.f : 1.f, z1 = r1 < 0 ? 0.f : 1.f, z2 = r2 < 0 ? 0.f : 1.f, z3 = r3 < 0 ? 0.f : 1.f;
    float c00 = 0, c01 = 0, c02 = 0, c03 = 0, c10 = 0, c11 = 0, c12 = 0, c13 = 0, c20 = 0, c21 = 0, c22 = 0, c23 = 0, c30 = 0, c31 = 0, c32 = 0, c33 = 0;
    for (int k = 0; k < K; ++k) {
        const float* bp = Bp + (size_t)k * ldb; const float b0 = bp[0], b1 = bp[1], b2 = bp[2], b3 = bp[3];
        const float x0 = a0[k] * z0, x1 = a1[k] * z1, x2 = a2[k] * z2, x3 = a3[k] * z3;
        c00 += x0 * b0; c01 += x0 * b1; c02 += x0 * b2; c03 += x0 * b3;
        c10 += x1 * b0; c11 += x1 * b1; c12 += x1 * b2; c13 += x1 * b3;
        c20 += x2 * b0; c21 += x2 * b1; c22 += x2 * b2; c23 += x2 * b3;
        c30 += x3 * b0; c31 += x3 * b1; c32 += x3 * b2; c33 += x3 * b3;
    }
    float q0 = 0, q1 = 0, q2 = 0, q3 = 0; if (bias) { q0 = bias[n0]; q1 = bias[n0 + 1]; q2 = bias[n0 + 2]; q3 = bias[n0 + 3]; }
    float* c = C + (size_t)m0 * ldc + n0;
    c[0] = c00 + q0; c[1] = c01 + q1; c[2] = c02 + q2; c[3] = c03 + q3; c += ldc;
    c[0] = c10 + q0; c[1] = c11 + q1; c[2] = c12 + q2; c[3] = c13 + q3; c += ldc;
    c[0] = c20 + q0; c[1] = c21 + q1; c[2] = c22 + q2; c[3] = c23 + q3; c += ldc;
    c[0] = c30 + q0; c[1] = c31 + q1; c[2] = c32 + q2; c[3] = c33 + q3;
}
__device__ __forceinline__ void d_sgu_ln(size_t t, const bf16_t* P, const float* g, const float* b, float* VN, const Dims& dm) {
    const bf16_t* v = P + t * IN_W + OFF_V; float s = 0.f;
    for (int c = 0; c < SGU_W; ++c) s += bf2f(v[c]);
    const float mu = s / SGU_W; float q = 0.f;
    for (int c = 0; c < SGU_W; ++c) { const float d = bf2f(v[c]) - mu; q += d * d; }
    const float rstd = 1.0f / sqrtf(q / SGU_W + LN_EPS);
    for (int c = 0; c < SGU_W; ++c) VN[t * SGU_W + c] = (bf2f(v[c]) - mu) * rstd * g[c] + b[c];
}
__device__ __forceinline__ void d_sgu_mix(size_t i, const bf16_t* P, const float* VN, const float* w_sp, const float* b_sp, bf16_t* AO, const Dims& dm) {
    const int t = (int)(i / SGU_W), col = (int)(i % SGU_W), g = col / SGU_GW, p = t % dm.TPB, pp = p % CHUNK; const size_t base = (size_t)t - pp;
    const float* w = w_sp + ((size_t)g * CHUNK + pp) * CHUNK; float acc = 0.f;
    for (int q = 0; q < CHUNK; ++q) acc += w[q] * VN[(base + q) * SGU_W + col];
    AO[(size_t)t * ABR_LD + col] = f2bf(bf2f(P[(size_t)t * IN_W + OFF_U + col]) * (acc + b_sp[g * CHUNK + pp]));
}
__device__ __forceinline__ void d_rope(size_t i, const bf16_t* P, float* QK, const Dims& dm) {
    const int t = (int)(i / 640), j = (int)(i % 640), p = t % dm.TPB;
    const int src = j < 512 ? OFF_Q + j : OFF_K + (j - 512);
    const bf16_t* row = P + (size_t)t * IN_W;
    if (p < CTX) { QK[i] = bf2f(row[src]); return; }
    const int pos = p - CTX, e = j & 63, half = e >> 5, f = e & 31, fi = f & 15;
    const float coord = (float)(half ? (pos % 64) : (pos / 64));
    const float inv = powf(10000.0f, -(float)(2 * fi) / 32.0f);
    const float ang = coord * inv, cs = cosf(ang), sn = sinf(ang);
    const int hb = src - e + half * 32;
    const float x1 = bf2f(row[hb + fi]), x2 = bf2f(row[hb + 16 + fi]);
    QK[i] = f < 16 ? (x1 * cs - x2 * sn) : (x2 * cs + x1 * sn);
}
__device__ __forceinline__ void d_attn(size_t i, const float* QK, const bf16_t* P, const float* sink, bf16_t* BO, const Dims& dm) {
    const int t = (int)(i / NH), h = (int)(i % NH), kv = h / (NH / NKV), b = t / dm.TPB, p = t % dm.TPB;
    float q[HD], o[HD];
#pragma unroll
    for (int d = 0; d < HD; ++d) { q[d] = QK[(size_t)t * 640 + h * HD + d]; o[d] = 0.f; }
    float m = sink[h], l = 1.0f;
    const int tb = b * dm.TPB;
    int lo = 0, hi = -1;
    if (p >= CTX) { const int pos = p - CTX; lo = pos - WIN < 0 ? 0 : pos - WIN; hi = pos + WIN > dm.S - 1 ? dm.S - 1 : pos + WIN; }
    const int nloc = hi - lo + 1 > 0 ? hi - lo + 1 : 0;
    for (int jj = 0; jj < CTX + nloc; ++jj) {
        const int kt = tb + (jj < CTX ? jj : CTX + lo + (jj - CTX));
        const float* kr = QK + (size_t)kt * 640 + 512 + kv * HD; const bf16_t* vr = P + (size_t)kt * IN_W + OFF_VAL + kv * HD;
        float s = 0.f;
#pragma unroll
        for (int d = 0; d < HD; ++d) s += q[d] * kr[d];
        s *= 0.125f;
        if (s > m) { const float sc = expf(m - s); l *= sc;
#pragma unroll
            for (int d = 0; d < HD; ++d) o[d] *= sc;
            m = s; }
        const float pe = expf(s - m); l += pe;
#pragma unroll
        for (int d = 0; d < HD; ++d) o[d] += pe * bf2f(vr[d]);
    }
    const float il = 1.0f / l;
#pragma unroll
    for (int d = 0; d < HD; ++d) BO[(size_t)t * ATT_W + h * HD + d] = f2bf(o[d] * il);
}
__device__ __forceinline__ float conv_at(const bf16_t* P, const float* cw, const float* cb, int dir, int b, int p, int ch, const Dims& dm) {
    const int s0 = p < CTX ? 0 : CTX, s1 = p < CTX ? CTX : dm.TPB;
    const float* w = cw + (size_t)dir * 4 * LRU_W + ch; float out = cb[dir * LRU_W + ch];
    const bf16_t* xp = P + (size_t)b * dm.TPB * IN_W + OFF_XR + ch;
#pragma unroll
    for (int j = 0; j < 4; ++j) { const int pp = dir ? p + j : p + j - 3; if (pp >= s0 && pp < s1) out += w[j * LRU_W] * bf2f(xp[(size_t)pp * IN_W]); }
    return out;
}
__device__ __forceinline__ void d_lru_gates(size_t i, const bf16_t* P, const float* cw, const float* cb, const float* wr, const float* br, const float* wi, const float* bi,
                                            const float* lam, float* AA, float* UU, const Dims& dm) {
    const int dir = (int)(i / ((size_t)dm.T * LRU_W)); const size_t rem = i % ((size_t)dm.T * LRU_W);
    const int t = (int)(rem / LRU_W), ch = (int)(rem % LRU_W), blk = ch / LRU_BW, dc = ch % LRU_BW, b = t / dm.TPB, p = t % dm.TPB;
    const float* wrp = wr + ((size_t)(dir * 8 + blk) * LRU_BW) * LRU_BW + dc; const float* wip = wi + ((size_t)(dir * 8 + blk) * LRU_BW) * LRU_BW + dc;
    float ar = 0.f, ai = 0.f;
    for (int c = 0; c < LRU_BW; ++c) { const float tv = conv_at(P, cw, cb, dir, b, p, blk * LRU_BW + c, dm); ar += tv * wrp[(size_t)c * LRU_BW]; ai += tv * wip[(size_t)c * LRU_BW]; }
    const float r = sigmoidf_(ar + br[dir * LRU_W + ch]), ig = sigmoidf_(ai + bi[dir * LRU_W + ch]);
    const float nl = -lam[dir * LRU_W + ch]; const float sp = nl > 20.f ? nl : log1pf(expf(nl));
    const float log_a = -8.0f * r * sp; const float a = expf(log_a); const float mult = sqrtf(-expm1f(2.0f * log_a));
    const float tv = conv_at(P, cw, cb, dir, b, p, ch, dm);
    AA[i] = a; UU[i] = mult * ig * tv;
}
__device__ __forceinline__ void d_lru_scan(size_t i, const float* AA, float* UU, const Dims& dm) {
    const int dir = (int)(i / (NB * LRU_W)), b = (int)((i / LRU_W) % NB), ch = (int)(i % LRU_W);
    const size_t base = ((size_t)dir * dm.T + (size_t)b * dm.TPB) * LRU_W + ch; float h = 0.f;
    if (!dir) {
#pragma unroll 8
        for (int p = 0; p < dm.TPB; ++p) { const size_t o = base + (size_t)p * LRU_W; h = AA[o] * h + UU[o]; UU[o] = h; }
    } else {
#pragma unroll 8
        for (int p = CTX - 1; p >= 0; --p) { const size_t o = base + (size_t)p * LRU_W; h = AA[o] * h + UU[o]; UU[o] = h; }
#pragma unroll 8
        for (int p = dm.TPB - 1; p >= CTX; --p) { const size_t o = base + (size_t)p * LRU_W; h = AA[o] * h + UU[o]; UU[o] = h; }
    }
}
__device__ __forceinline__ void d_lru_out(size_t i, const bf16_t* P, const float* HH, bf16_t* RO, const Dims& dm) {
    const int t = (int)(i / LRU_W), ch = (int)(i % LRU_W);
    RO[i] = f2bf((HH[i] + HH[(size_t)dm.T * LRU_W + i]) * geluf_(bf2f(P[(size_t)t * IN_W + OFF_Z + ch])));
}
__device__ __forceinline__ void d_merge(size_t i, const bf16_t* P, const float* PA, const float* PB, const float* PC, bf16_t* Y, const Dims& dm) {
    const int t = (int)(i / D), n = (int)(i % D); const bf16_t* g = P + (size_t)t * IN_W + OFF_G + n;
    Y[i] = f2bf(bf2f(g[0]) * PA[i] + bf2f(g[D]) * PB[i] + bf2f(g[2 * D]) * PC[i]);
}
__device__ __forceinline__ void d_ln_res(size_t t, float* X, const float* Yv, const float* MODl, int gi, const float* g, const float* bb, float alpha, const Dims& dm) {
    const int b = (int)(t / dm.TPB), p = (int)(t % dm.TPB), row = p < CTX ? NB : b;
    const float* m = MODl + (size_t)row * NMOD * D + gi * D; float* x = X + t * D; const float* y = Yv + t * D;
    float s = 0.f; for (int d = 0; d < D; ++d) s += alpha * x[d] + m[d] * y[d];
    const float mu = s / D; float q = 0.f;
    for (int d = 0; d < D; ++d) { const float v = alpha * x[d] + m[d] * y[d] - mu; q += v * v; }
    const float rstd = 1.0f / sqrtf(q / D + LN_EPS);
    for (int d = 0; d < D; ++d) x[d] = (alpha * x[d] + m[d] * y[d] - mu) * rstd * g[d] + bb[d];
}
__device__ __forceinline__ void d_route(size_t t, const float* H, const float* wg, const float* bg, const float* wrt, const float* brt, int* expert, float* gate, int* counts, const Dims& dm) {
    const float* h = H + t * D; float g0 = 0, g1 = 0, g2 = 0, g3 = 0;
    for (int k = 0; k < D; ++k) { const float hv = h[k]; const float* w = wg + (size_t)k * NGRP; g0 += hv * w[0]; g1 += hv * w[1]; g2 += hv * w[2]; g3 += hv * w[3]; }
    g0 += bg[0]; g1 += bg[1]; g2 += bg[2]; g3 += bg[3];
    int gi = 0; float gm = g0; if (g1 > gm) { gm = g1; gi = 1; } if (g2 > gm) { gm = g2; gi = 2; } if (g3 > gm) { gm = g3; gi = 3; }
    const float gw = 1.0f / (expf(g0 - gm) + expf(g1 - gm) + expf(g2 - gm) + expf(g3 - gm));
    float e0 = 0, e1 = 0, e2 = 0, e3 = 0, e4 = 0, e5 = 0, e6 = 0, e7 = 0;
    for (int k = 0; k < D; ++k) { const float hv = h[k]; const float* w = wrt + (size_t)k * NEXP + gi * EPG;
        e0 += hv * w[0]; e1 += hv * w[1]; e2 += hv * w[2]; e3 += hv * w[3]; e4 += hv * w[4]; e5 += hv * w[5]; e6 += hv * w[6]; e7 += hv * w[7]; }
    const float* bp = brt + gi * EPG;
    e0 += bp[0]; e1 += bp[1]; e2 += bp[2]; e3 += bp[3]; e4 += bp[4]; e5 += bp[5]; e6 += bp[6]; e7 += bp[7];
    int j0 = 0; float v0 = e0;
    if (e1 > v0) { v0 = e1; j0 = 1; } if (e2 > v0) { v0 = e2; j0 = 2; } if (e3 > v0) { v0 = e3; j0 = 3; } if (e4 > v0) { v0 = e4; j0 = 4; }
    if (e5 > v0) { v0 = e5; j0 = 5; } if (e6 > v0) { v0 = e6; j0 = 6; } if (e7 > v0) { v0 = e7; j0 = 7; }
    int j1 = -1; float v1 = -3.0e38f;
    if (j0 != 0 && e0 > v1) { v1 = e0; j1 = 0; } if (j0 != 1 && e1 > v1) { v1 = e1; j1 = 1; } if (j0 != 2 && e2 > v1) { v1 = e2; j1 = 2; } if (j0 != 3 && e3 > v1) { v1 = e3; j1 = 3; }
    if (j0 != 4 && e4 > v1) { v1 = e4; j1 = 4; } if (j0 != 5 && e5 > v1) { v1 = e5; j1 = 5; } if (j0 != 6 && e6 > v1) { v1 = e6; j1 = 6; } if (j0 != 7 && e7 > v1) { v1 = e7; j1 = 7; }
    const float p1 = expf(v1 - v0), inv = 1.0f / (1.0f + p1);
    expert[t * 2] = gi * EPG + j0; expert[t * 2 + 1] = gi * EPG + j1; gate[t * 2] = gw * inv; gate[t * 2 + 1] = gw * p1 * inv;
    atomicAdd(&counts[gi * EPG + j0], 1); atomicAdd(&counts[gi * EPG + j1], 1);
}
__device__ __forceinline__ void d_moe_offsets(const int* counts, int* pad_start, int* blk_e, int* fill, const Dims& dm) {
    int acc = 0;
    for (int e = 0; e < NEXP; ++e) { pad_start[e] = acc; fill[e] = 0; const int pc = (counts[e] + 127) / 128 * 128; for (int b = acc / 128; b < (acc + pc) / 128; ++b) blk_e[b] = e; acc += pc; }
    for (int b = acc / 128; b < dm.nslots / 128; ++b) blk_e[b] = NEXP - 1;
}
__device__ __forceinline__ void d_moe_scatter(size_t i, const int* expert, const int* pad_start, int* fill, int* slot_of, int* tok_of_slot, const Dims& dm) {
    const int e = expert[i]; const int pos = atomicAdd(&fill[e], 1); const int slot = pad_start[e] + pos;
    slot_of[i] = slot; tok_of_slot[slot] = (int)(i / 2);
}
__device__ __forceinline__ void d_moe_combine(size_t i, const float* O, const int* slot_of, const float* gate, float* F, const Dims& dm) {
    const int t = (int)(i / D), d = (int)(i % D);
    F[i] = gate[t * 2] * O[(size_t)slot_of[t * 2] * D + d] + gate[t * 2 + 1] * O[(size_t)slot_of[t * 2 + 1] * D + d];
}

constexpr float QSCALE = 0.18033688011112042f;
__device__ __forceinline__ void d_rope_table(size_t i, float* ROPE) {
    const int coord = (int)(i / 16), fi = (int)(i % 16); const float ang = (float)coord * powf(10000.0f, -(float)(2 * fi) / 32.0f);
    ROPE[i] = cosf(ang); ROPE[128 * 16 + i] = sinf(ang);
}
__device__ __forceinline__ void d_inproj_act(size_t i, bf16_t* P, bf16_t* VT, const float* ROPE, const Dims& dm) {
    const size_t t = i / (IN_W / 2); const int r = (int)(i % (IN_W / 2)), c0 = (r / 16) * 32 + (r % 16), c1 = c0 + 16, fi = r % 16;
    const int b = (int)(t / dm.TPB), p = (int)(t % dm.TPB);
    bf16_t* row = P + t * IN_W; float x0 = bf2f(row[c0]), x1 = bf2f(row[c1]);
    const bool isq = c0 < OFF_U, isk = (c0 >= OFF_K && c0 < OFF_VAL);
    if (isq || isk) {
        if (p >= CTX) { const int pos = p - CTX, axis = (c0 / 32) & 1, coord = axis ? (pos % 64) : (pos / 64); const float cs = ROPE[coord * 16 + fi], sn = ROPE[128 * 16 + coord * 16 + fi];
            const float y0 = x0 * cs - x1 * sn, y1 = x1 * cs + x0 * sn; x0 = y0; x1 = y1; }
        if (isq) { x0 *= QSCALE; x1 *= QSCALE; }
    } else if ((c0 >= OFF_U && c0 < OFF_G) || (c0 >= OFF_Z && c0 < OFF_K)) { x0 = geluf_(x0); x1 = geluf_(x1); }
    else if (c0 >= OFF_G && c0 < OFF_Z) { x0 = sigmoidf_(x0); x1 = sigmoidf_(x1); }
    else if (c0 >= OFF_VAL && c0 < OFF_XR) { const int d0 = c0 - OFF_VAL, d1 = c1 - OFF_VAL;
        VT[((size_t)(b * NKV + d0 / HD) * HD + d0 % HD) * dm.TPB + p] = f2bf(x0); VT[((size_t)(b * NKV + d1 / HD) * HD + d1 % HD) * dm.TPB + p] = f2bf(x1); }
    row[c0] = f2bf(x0); row[c1] = f2bf(x1);
}
__device__ __forceinline__ void d_attn_ref(size_t i, const bf16_t* P, const bf16_t* VT, const float* sink, bf16_t* BO, const Dims& dm) {
    const int t = (int)(i / NH), h = (int)(i % NH), kv = h / (NH / NKV), b = t / dm.TPB, p = t % dm.TPB;
    float q[HD], o[HD];
    for (int d = 0; d < HD; ++d) { q[d] = bf2f(P[(size_t)t * IN_W + OFF_Q + h * HD + d]); o[d] = 0.f; }
    float m = sink[h] * 1.4426950408889634f, l = 1.0f;
    int lo = 0, hi = -1;
    if (p >= CTX) { const int pos = p - CTX; lo = pos - WIN < 0 ? 0 : pos - WIN; hi = pos + WIN > dm.S - 1 ? dm.S - 1 : pos + WIN; }
    const int nloc = hi - lo + 1 > 0 ? hi - lo + 1 : 0;
    for (int jj = 0; jj < CTX + nloc; ++jj) {
        const int kp = jj < CTX ? jj : CTX + lo + (jj - CTX); const bf16_t* kr = P + ((size_t)b * dm.TPB + kp) * IN_W + OFF_K + kv * HD;
        float s = 0.f; for (int d = 0; d < HD; ++d) s += q[d] * bf2f(kr[d]);
        if (s > m) { const float sc = exp2f(m - s); l *= sc; for (int d = 0; d < HD; ++d) o[d] *= sc; m = s; }
        const float pe = bf2f(f2bf(exp2f(s - m))); l += pe;
        for (int d = 0; d < HD; ++d) o[d] += pe * bf2f(VT[((size_t)(b * NKV + kv) * HD + d) * dm.TPB + kp]);
    }
    for (int d = 0; d < HD; ++d) BO[(size_t)t * ABR_LD + h * HD + d] = f2bf(o[d] / l);
}

__device__ __forceinline__ float softplus_neg(float lam) { const float nl = -lam; return nl > 20.f ? nl : log1pf(expf(nl)); }
__device__ __forceinline__ float one_minus_exp(float x) {
    return x > -0.125f ? -x * (1.0f + x * (0.5f + x * (0.16666667f + x * (0.041666668f + x * 0.0083333338f)))) : 1.0f - expf(x); }
__device__ __forceinline__ void d_lru_local_ref(size_t i, const bf16_t* P, const float* cw, const float* cb, const float* wr, const float* br, const float* wi, const float* bi, const float* cchp,
                                                bf16_t* HL, bf16_t* AC, float* SUMA, float* SUMH, const Dims& dm) {
    const int nch = dm.T / CHUNK, ch = (int)(i % LRU_W), q = (int)((i / LRU_W) % nch), dir = (int)(i / ((size_t)LRU_W * nch));
    const int cpb = dm.TPB / CHUNK, b = q / cpb, p0 = (q % cpb) * CHUNK, blk = ch / LRU_BW, dc = ch % LRU_BW;
    const float* wrp = wr + ((size_t)(dir * 8 + blk) * LRU_BW) * LRU_BW + dc; const float* wip = wi + ((size_t)(dir * 8 + blk) * LRU_BW) * LRU_BW + dc;
    const float cch = cchp[dir * LRU_W + ch];
    float h = 0.f, A = 1.f;
    for (int s_ = 0; s_ < CHUNK; ++s_) {
        const int p = p0 + (dir ? CHUNK - 1 - s_ : s_); float ar = 0.f, ai = 0.f;
        for (int c = 0; c < LRU_BW; ++c) { const float tv = bf2f(f2bf(conv_at(P, cw, cb, dir, b, p, blk * LRU_BW + c, dm))); ar += tv * bf2f(f2bf(wrp[(size_t)c * LRU_BW])); ai += tv * bf2f(f2bf(wip[(size_t)c * LRU_BW])); }
        const float r = sigmoidf_(ar + br[dir * LRU_W + ch]), ig = sigmoidf_(ai + bi[dir * LRU_W + ch]);
        const float la = cch * r, a = expf(la), mult = sqrtf(one_minus_exp(2.0f * la));
        const float tv = bf2f(f2bf(conv_at(P, cw, cb, dir, b, p, ch, dm)));
        h = a * h + mult * ig * tv; A *= a;
        const size_t o = ((size_t)dir * dm.T + (size_t)b * dm.TPB + p) * LRU_W + ch; HL[o] = f2bf(h); AC[o] = f2bf(A);
    }
    SUMA[((size_t)dir * nch + q) * LRU_W + ch] = A; SUMH[((size_t)dir * nch + q) * LRU_W + ch] = h;
}
__device__ __forceinline__ float lru_carry(const float* SUMA, const float* SUMH, int nch, int cpb, int dir, int b, int cq, int ch) {
    const float* sa = SUMA + ((size_t)dir * nch + (size_t)b * cpb) * LRU_W + ch; const float* sh = SUMH + ((size_t)dir * nch + (size_t)b * cpb) * LRU_W + ch; float c = 0.f;
    if (!dir) { for (int k = 0; k < cq; ++k) c = sa[(size_t)k * LRU_W] * c + sh[(size_t)k * LRU_W]; }
    else { if (cq == 0 || cq >= 2) c = sh[(size_t)1 * LRU_W];
           if (cq >= 2) { c = sa[0] * c + sh[0]; for (int k = cpb - 1; k > cq; --k) c = sa[(size_t)k * LRU_W] * c + sh[(size_t)k * LRU_W]; } }
    return c;
}
__device__ __forceinline__ void d_lru_fix_ref(size_t i, const bf16_t* P, const bf16_t* HL, const bf16_t* AC, const float* SUMA, const float* SUMH, bf16_t* RO, const Dims& dm) {
    const int t = (int)(i / LRU_W), ch = (int)(i % LRU_W), b = t / dm.TPB, p = t % dm.TPB, cq = p / CHUNK, nch = dm.T / CHUNK, cpb = dm.TPB / CHUNK;
    const float c0 = lru_carry(SUMA, SUMH, nch, cpb, 0, b, cq, ch), c1 = lru_carry(SUMA, SUMH, nch, cpb, 1, b, cq, ch);
    const size_t o0 = (size_t)t * LRU_W + ch, o1 = ((size_t)dm.T + t) * LRU_W + ch;
    RO[(size_t)t * ABR_LD + ch] = f2bf((bf2f(HL[o0]) + bf2f(AC[o0]) * c0 + bf2f(HL[o1]) + bf2f(AC[o1]) * c1) * bf2f(P[(size_t)t * IN_W + OFF_Z + ch]));
}

__device__ __forceinline__ void d_ln1_route(size_t t, const float* X0, float* X, const float* YO, const float* MODl, const float* g, const float* bb, float alpha, bf16_t* Hb,
                                            const float* wg, const float* bg, const float* wrt, const float* brt, int* cnt, int* list, int cap, int* tokinfo, float* tokgate, const Dims& dm) {
    for (int d = 0; d < D; ++d) X[t * D + d] = X0[t * D + d];
    d_ln_res(t, X, YO, MODl, 2, g, bb, alpha, dm);
    const int b = (int)(t / dm.TPB), p = (int)(t % dm.TPB), row = p < CTX ? NB : b;
    const float* m = MODl + (size_t)row * NMOD * D; const float* x = X + t * D;
    for (int d = 0; d < D; ++d) Hb[t * D + d] = f2bf(x[d] * (1.0f + m[4 * D + d]) + m[3 * D + d]);
    float g0 = 0, g1 = 0, g2 = 0, g3 = 0;
    for (int k = 0; k < D; ++k) { const float hv = x[k] * (1.0f + m[4 * D + k]) + m[3 * D + k]; const float* w = wg + (size_t)k * NGRP; g0 += hv * w[0]; g1 += hv * w[1]; g2 += hv * w[2]; g3 += hv * w[3]; }
    g0 += bg[0]; g1 += bg[1]; g2 += bg[2]; g3 += bg[3];
    int gi = 0; float gm = g0; if (g1 > gm) { gm = g1; gi = 1; } if (g2 > gm) { gm = g2; gi = 2; } if (g3 > gm) { gm = g3; gi = 3; }
    const float gw = 1.0f / (expf(g0 - gm) + expf(g1 - gm) + expf(g2 - gm) + expf(g3 - gm));
    float ev[8] = {0, 0, 0, 0, 0, 0, 0, 0};
    for (int k = 0; k < D; ++k) { const float hv = x[k] * (1.0f + m[4 * D + k]) + m[3 * D + k]; const float* w = wrt + (size_t)k * NEXP + gi * EPG; for (int j = 0; j < 8; ++j) ev[j] += hv * w[j]; }
    for (int j = 0; j < 8; ++j) ev[j] += brt[gi * EPG + j];
    int j0 = 0; for (int j = 1; j < 8; ++j) if (ev[j] > ev[j0]) j0 = j;
    int j1 = -1; for (int j = 0; j < 8; ++j) if (j != j0 && (j1 < 0 || ev[j] > ev[j1])) j1 = j;
    const float p1 = expf(ev[j1] - ev[j0]), inv = 1.0f / (1.0f + p1);
    const int e0 = gi * EPG + j0, e1 = gi * EPG + j1;
    const int pos0 = atomicAdd(&cnt[e0 * CNT_STRIDE], 1), pos1 = atomicAdd(&cnt[e1 * CNT_STRIDE], 1);
    list[(size_t)e0 * cap + pos0] = (int)t; list[(size_t)e1 * cap + pos1] = (int)t;
    tokinfo[t * 4] = e0; tokinfo[t * 4 + 1] = pos0; tokinfo[t * 4 + 2] = e1; tokinfo[t * 4 + 3] = pos1; tokgate[t * 2] = gw * inv; tokgate[t * 2 + 1] = gw * p1 * inv;
}
__device__ __forceinline__ void d_moe_tst(const int* cnt, int* tst) { int acc = 0; for (int e = 0; e < NEXP; ++e) { tst[e] = acc; acc += (cnt[e * CNT_STRIDE] + 255) / 256; } tst[NEXP] = acc; }
__device__ __forceinline__ int moe_expert_of_tile(const int* tst, int q) { int e = 0; for (int k = 1; k < NEXP; ++k) e += (tst[k] <= q) ? 1 : 0; return e; }
__device__ __forceinline__ void d_moe1_ref(size_t i, const bf16_t* Hb, const float* w1, const float* w3, const int* cnt, const int* tst, const int* list, int cap, bf16_t* HH) {
    const int j = (int)(i % DEXP); const size_t slot = i / DEXP; const int q = (int)(slot / 256), rr = (int)(slot % 256), e = moe_expert_of_tile(tst, q), r = q - tst[e];
    const int tok = (256 * r + rr < cnt[e * CNT_STRIDE]) ? list[(size_t)e * cap + 256 * r + rr] : 0;
    const float* a1 = w1 + (size_t)e * D * DEXP + j; const float* a3 = w3 + (size_t)e * D * DEXP + j; float sa = 0.f, sb = 0.f;
    for (int k = 0; k < D; ++k) { const float hv = bf2f(Hb[(size_t)tok * D + k]); sa += hv * bf2f(f2bf(a1[(size_t)k * DEXP])); sb += hv * bf2f(f2bf(a3[(size_t)k * DEXP])); }
    HH[slot * DEXP + j] = f2bf(sa / (1.0f + expf(-sa)) * sb);
}
__device__ __forceinline__ void d_moe2_ref(size_t i, const bf16_t* HH, const float* w2, const int* tst, bf16_t* O) {
    const int n = (int)(i % D); const size_t slot = i / D; const int q = (int)(slot / 256), e = moe_expert_of_tile(tst, q);
    const float* a = w2 + (size_t)e * DEXP * D + n; float acc = 0.f;
    for (int k = 0; k < DEXP; ++k) acc += bf2f(HH[slot * DEXP + k]) * bf2f(f2bf(a[(size_t)k * D]));
    O[slot * D + n] = f2bf(acc);
}
__device__ __forceinline__ void d_combine_ln2(size_t t, const float* X1, float* X, const bf16_t* O, const int* tst, const int* tokinfo, const float* tokgate, const float* MODl, const float* MODn,
                                              const float* g, const float* bb, float alpha, bf16_t* Hb, float* out, const Dims& dm) {
    const int b = (int)(t / dm.TPB), p = (int)(t % dm.TPB), row = p < CTX ? NB : b;
    const float* m = MODl + (size_t)row * NMOD * D + 5 * D; float* x = X + t * D; for (int d = 0; d < D; ++d) x[d] = X1[t * D + d];
    const size_t s0 = (size_t)256 * tst[tokinfo[t * 4]] + tokinfo[t * 4 + 1], s1 = (size_t)256 * tst[tokinfo[t * 4 + 2]] + tokinfo[t * 4 + 3];
    const float g0 = tokgate[t * 2], g1 = tokgate[t * 2 + 1];
    float s = 0.f; for (int d = 0; d < D; ++d) s += alpha * x[d] + m[d] * (g0 * bf2f(O[s0 * D + d]) + g1 * bf2f(O[s1 * D + d]));
    const float mu = s / D; float q = 0.f;
    for (int d = 0; d < D; ++d) { const float v = alpha * x[d] + m[d] * (g0 * bf2f(O[s0 * D + d]) + g1 * bf2f(O[s1 * D + d])) - mu; q += v * v; }
    const float rstd = 1.0f / sqrtf(q / D + LN_EPS);
    for (int d = 0; d < D; ++d) { const float xn = (alpha * x[d] + m[d] * (g0 * bf2f(O[s0 * D + d]) + g1 * bf2f(O[s1 * D + d])) - mu) * rstd * g[d] + bb[d]; x[d] = xn;
        if (MODn) { const float* mn = MODn + (size_t)row * NMOD * D; Hb[t * D + d] = f2bf(xn * (1.0f + mn[D + d]) + mn[d]); }
        else if (p >= CTX) out[((size_t)b * dm.S + (p - CTX)) * D + d] = xn; }
}

struct In {
    const float *x, *c, *ctx, *c_ctx, *w_mod, *b_mod, *w_in, *b_in, *sgu_ln_g, *sgu_ln_b, *w_spatial, *b_spatial, *attn_sink, *conv_w, *conv_b,
        *w_rgate, *b_rgate, *w_igate, *b_igate, *lru_lambda, *w_proj_a, *w_proj_b, *w_proj_c, *w_out, *b_out, *ln1_g, *ln1_b, *ln2_g, *ln2_b,
        *w_group, *b_group, *w_router, *b_router, *w1, *w3, *w2;
};


constexpr size_t WS_CTL = 0, CTL_BYTES = 65536;
constexpr size_t WS_YCTXFLAG = 53248;
constexpr size_t WS_CARRYFLAG = 49152;
struct Bufs {
    size_t ws_end;
    float *MOD, *X, *H, *gate, *AA, *UU, *VN, *QK, *PA, *PB, *PC, *YO, *G1, *G3, *HH, *O, *F;
    bf16_t *Hb, *P, *AO, *BO, *RO, *Y;
    bf16_t *Win_t, *Wabc_t, *Wo_t, *PS;
    int *expert, *slot_of, *tok_of_slot, *counts, *pad_start, *fill, *blk_e;
    int *cnt, *tst, *list, *tokinfo; float* tokgate; bf16_t *W13_t, *W2_t, *HHb, *Ob;
    bf16_t *Wsp_b;
    bf16_t *VT; float* ROPE;
    bf16_t *HL, *AC, *Wr_t, *Wi_t; float *SUMA, *SUMH, *CCH, *CARRY;
};
__host__ __device__ __forceinline__ size_t al256(size_t x) { return (x + 255) / 256 * 256; }
__host__ __device__ __forceinline__ Bufs make_bufs(char* ws, const Dims& dm) {
    const size_t T = dm.T, L = dm.L; Bufs b; size_t off = CTL_BYTES;
    b.MOD = (float*)(ws + off); off += al256(L * (NB + 1) * NMOD * D * 4);
    b.X = (float*)(ws + off); off += al256(T * D * 4);
    b.H = (float*)(ws + off); off += al256(T * D * 4);
    b.Hb = (bf16_t*)(ws + off); off += al256(T * D * 2);
    b.AO = (bf16_t*)(ws + off); off += al256(T * ABR_LD * 2); b.BO = b.AO + SGU_W; b.RO = b.AO + SGU_W + ATT_W;
    b.Y = (bf16_t*)(ws + off); off += al256(T * D * 2);
    b.expert = (int*)(ws + off); off += al256(T * 2 * 4);
    b.gate = (float*)(ws + off); off += al256(T * 2 * 4);
    b.slot_of = (int*)(ws + off); off += al256(T * 2 * 4);
    b.tok_of_slot = (int*)(ws + off); off += al256((size_t)dm.nslots * 4);
    b.counts = (int*)(ws + off); off += 256; b.pad_start = (int*)(ws + off); off += 256; b.fill = (int*)(ws + off); off += 256;
    b.blk_e = (int*)(ws + off); off += al256((size_t)(dm.nslots / 128) * 4);
    b.cnt = (int*)(ws + off); off += NEXP * CNT_STRIDE * 4; b.tst = (int*)(ws + off); off += 256;
    b.list = (int*)(ws + off); off += al256((size_t)NEXP * (T * 2) * 4);
    b.tokinfo = (int*)(ws + off); off += al256(T * 4 * 4);
    b.tokgate = (float*)(ws + off); off += al256(T * 2 * 4);
    b.W13_t = (bf16_t*)(ws + off); off += al256((size_t)NEXP * 2 * DEXP * D * 2);
    b.W2_t = (bf16_t*)(ws + off); off += al256((size_t)NEXP * D * DEXP * 2);
    b.CCH = (float*)(ws + off); off += al256(L * 2 * LRU_W * 4);
    b.ROPE = (float*)(ws + off); off += al256(2 * 128 * 16 * 4);
    b.Wsp_b = (bf16_t*)(ws + off); off += al256(L * 4 * CHUNK * CHUNK * 2);
    b.VT = (bf16_t*)(ws + off); off += al256(T * KV_W * 2);
    b.CARRY = (float*)(ws + off); off += al256((size_t)2 * (T / CHUNK) * LRU_W * 4);
    b.SUMA = (float*)(ws + off); off += al256((size_t)2 * (T / CHUNK) * LRU_W * 4);
    b.SUMH = (float*)(ws + off); off += al256((size_t)2 * (T / CHUNK) * LRU_W * 4);
    b.Wr_t = (bf16_t*)(ws + off); off += al256(L * 2 * 8 * LRU_BW * LRU_BW * 2);
    b.Wi_t = (bf16_t*)(ws + off); off += al256(L * 2 * 8 * LRU_BW * LRU_BW * 2);
    b.Win_t = (bf16_t*)(ws + off); off += al256(L * IN_W * D * 2);
    b.Wabc_t = (bf16_t*)(ws + off); off += al256(L * D * ABR_LD * 2);
    b.Wo_t = (bf16_t*)(ws + off); off += al256(L * D * D * 2);
    const size_t pbytes = T * IN_W * 2, mbytes = (size_t)dm.nslots * (3 * DEXP + D) * 4;
    b.P = (bf16_t*)(ws + off); off += al256(pbytes > mbytes ? pbytes : mbytes);
    char* S1 = ws + off; off += al256(T * LRU_W * 4 * 3);
    b.AA = (float*)S1; b.UU = b.AA + 2 * T * LRU_W;
    b.HL = (bf16_t*)S1; b.AC = b.HL + 2 * T * LRU_W;
    b.VN = (float*)b.Y; b.QK = (float*)(S1 + T * SGU_W * 4);
    b.PA = (float*)S1; b.PB = b.PA + T * D; b.PC = b.PB + T * D;
    b.PS = (bf16_t*)(S1 + T * D * 4);
    b.YO = b.PA;
    b.G1 = (float*)b.P; b.G3 = b.G1 + (size_t)dm.nslots * DEXP; b.HH = b.G3 + (size_t)dm.nslots * DEXP; b.O = b.HH + (size_t)dm.nslots * DEXP;
    b.F = (float*)S1;
    const size_t nsl = ((T * 2 + 255) / 256 + NEXP) * 256;
    b.ws_end = off; b.HHb = b.P; b.Ob = b.P + nsl * DEXP;
    return b;
}

struct Args { In in; Bufs B; float* out; char* ws; Dims dm; };
#ifndef CPU_SHIM
__device__ __forceinline__ int ltid() { int t = threadIdx.x; asm volatile("" : "+v"(t)); return t; }
constexpr int NWG = 256;
constexpr int RING_OFF = 0, RING_BYTES = 131072;
constexpr int MISC_OFF = RING_BYTES;
constexpr int LDS_BYTES = 147456;
typedef unsigned v4u __attribute__((ext_vector_type(4)));
typedef float f32x4 __attribute__((ext_vector_type(4)));
typedef unsigned u32x2 __attribute__((ext_vector_type(2)));
__device__ __forceinline__ unsigned pk2(float lo, float hi) { return cvt_pk_bf16(lo, hi); }
struct TileSrc { const float* W; int N, k0, n0; bf16_t* WTr; int ldt; };
__device__ __forceinline__ void tile_load(const TileSrc& t, int lane, f32x4 (&v)[8]) {
    const int r8 = lane >> 3, c4 = lane & 7;
#pragma unroll
    for (int i = 0; i < 8; ++i) v[i] = *(const f32x4*)(t.W + (size_t)(t.k0 + r8 + 8 * i) * t.N + t.n0 + 4 * c4);
}
__device__ __forceinline__ void tile_store(const TileSrc& t, int lane, const f32x4 (&v)[8], LAS float* scr) {
    const int r8 = lane >> 3, c4 = lane & 7;
#pragma unroll
    for (int i = 0; i < 8; ++i) { LAS float* sp = scr + (r8 + 8 * i) * 33 + 4 * c4; sp[0] = v[i].x; sp[1] = v[i].y; sp[2] = v[i].z; sp[3] = v[i].w; }
    asm volatile("s_waitcnt lgkmcnt(0)" ::: "memory");
    const int c = lane & 7;
#pragma unroll
    for (int j = 0; j < 4; ++j) { const int n = (lane >> 3) + 8 * j; const LAS float* sp = scr + (8 * c) * 33 + n;
        v4u o; o.x = pk2(sp[0 * 33], sp[1 * 33]); o.y = pk2(sp[2 * 33], sp[3 * 33]); o.z = pk2(sp[4 * 33], sp[5 * 33]); o.w = pk2(sp[6 * 33], sp[7 * 33]);
        *(v4u*)(t.WTr + (size_t)n * t.ldt + t.k0 + 8 * c) = o; }
    asm volatile("s_waitcnt lgkmcnt(0)" ::: "memory");
}
__device__ __forceinline__ void p0_transpose_tile(const float* W, int K, int N, int k0, int n0, bf16_t* WTr, int ldt, LAS float* scr, int lane) {
    (void)K; const TileSrc t{W, N, k0, n0, WTr, ldt}; f32x4 v[8]; tile_load(t, lane, v); tile_store(t, lane, v, scr);
}
__device__ __forceinline__ void p0_transpose_item(const float* W, int K, int N, bf16_t* WT, LAS float* scr, int item, int lane) {
    const int nblk = N / 32, kb = item / nblk, nb = item % nblk;
    p0_transpose_tile(W, K, N, 64 * kb, 32 * nb, WT + (size_t)(32 * nb) * K, K, scr, lane);
}
__device__ __forceinline__ void p0_transpose_item_ld(const float* W, int K, int N, bf16_t* WT, int ldt, LAS float* scr, int item, int lane) {
    const int nblk = N / 32, kb = item / nblk, nb = item % nblk;
    p0_transpose_tile(W, K, N, 64 * kb, 32 * nb, WT + (size_t)(32 * nb) * ldt, ldt, scr, lane);
}
__device__ __forceinline__ TileSrc moe_weight_tile(const float* w1, const float* w3, const float* w2, bf16_t* W13_t, bf16_t* W2_t, int item) {
    const int which = item / (NEXP * 256), r = item % (NEXP * 256), e = r / 256, ti = r % 256;
    if (which < 2) { const int kb = ti / (DEXP / 32), nb = ti % (DEXP / 32), n0 = 32 * nb;
        return TileSrc{(which ? w3 : w1) + (size_t)e * D * DEXP, DEXP, 64 * kb, n0, W13_t + ((size_t)e * 1024 + (n0 / 128) * 256 + which * 128 + (n0 % 128)) * D, D}; }
    const int kb = ti / (D / 32), nb = ti % (D / 32), n0 = 32 * nb;
    return TileSrc{w2 + (size_t)e * DEXP * D, D, 64 * kb, n0, W2_t + ((size_t)e * 1024 + n0) * DEXP, DEXP};
}
#endif

#ifndef CPU_SHIM
__device__ __forceinline__ float wave_sum(float v, int lane) {
#pragma unroll
    for (int o = 1; o < 64; o <<= 1) v += __int_as_float(__builtin_amdgcn_ds_bpermute((lane ^ o) << 2, __float_as_int(v)));
    return v;
}
__device__ __forceinline__ float hsum4(f32x4 v) { return (v.x + v.y) + (v.z + v.w); }
__device__ __forceinline__ u32x2 pk4(f32x4 v) { u32x2 r; r.x = pk2(v.x, v.y); r.y = pk2(v.z, v.w); return r; }
__device__ __forceinline__ f32x4 unpk4(u32x2 r) { f32x4 v; v.x = __uint_as_float(r.x << 16); v.y = __uint_as_float(r.x & 0xffff0000u); v.z = __uint_as_float(r.y << 16); v.w = __uint_as_float(r.y & 0xffff0000u); return v; }
__device__ __forceinline__ void ln1_route_wave(int t, int lane, const float* X, float* X1, const float* YO, const float* MODl, const float* g1, const float* b1, float alpha, bf16_t* Hb,
                                               const float* wg, const float* bg, const LAS float* wrl, const float* brt, LAS int* lcnt, LAS int* rec, float* tokgate, const Dims& dm) {
    const int b = t / dm.TPB, p = t % dm.TPB, row = p < CTX ? NB : b;
    const float* m = MODl + (size_t)row * NMOD * D; const float* xr = X + (size_t)t * D; float* xw = X1 + (size_t)t * D; const float* yr = YO + (size_t)t * D;
    f32x4 v[4]; float s = 0.f;
#pragma unroll
    for (int j = 0; j < 4; ++j) { const int c = 256 * j + 4 * lane; v[j] = alpha * *(const f32x4*)(xr + c) + *(const f32x4*)(m + 2 * D + c) * *(const f32x4*)(yr + c); s += hsum4(v[j]); }
    const float mean = wave_sum(s, lane) * (1.0f / D); float q = 0.f;
#pragma unroll
    for (int j = 0; j < 4; ++j) { v[j] = v[j] - mean; q += hsum4(v[j] * v[j]); }
    const float rstd = 1.0f / sqrtf(wave_sum(q, lane) * (1.0f / D) + LN_EPS);
    float gl[4] = {0.f, 0.f, 0.f, 0.f};
#pragma unroll
    for (int j = 0; j < 4; ++j) { const int c = 256 * j + 4 * lane;
        const f32x4 xn = v[j] * rstd * *(const f32x4*)(g1 + c) + *(const f32x4*)(b1 + c); *(f32x4*)(xw + c) = xn;
        v[j] = xn * (1.0f + *(const f32x4*)(m + 4 * D + c)) + *(const f32x4*)(m + 3 * D + c);
        *(u32x2*)(Hb + (size_t)t * D + c) = pk4(v[j]);
#pragma unroll
        for (int e = 0; e < 4; ++e) { const f32x4 w = *(const f32x4*)(wg + (size_t)(c + e) * NGRP); gl[0] += v[j][e] * w.x; gl[1] += v[j][e] * w.y; gl[2] += v[j][e] * w.z; gl[3] += v[j][e] * w.w; } }
#pragma unroll
    for (int i = 0; i < 4; ++i) gl[i] = wave_sum(gl[i], lane) + bg[i];
    int gi = 0; float gm = gl[0]; if (gl[1] > gm) { gm = gl[1]; gi = 1; } if (gl[2] > gm) { gm = gl[2]; gi = 2; } if (gl[3] > gm) { gm = gl[3]; gi = 3; }
    const float gw = 1.0f / (expf(gl[0] - gm) + expf(gl[1] - gm) + expf(gl[2] - gm) + expf(gl[3] - gm));
    float ev[8] = {0.f, 0.f, 0.f, 0.f, 0.f, 0.f, 0.f, 0.f};
#pragma unroll
    for (int j = 0; j < 4; ++j) { const int c = 256 * j + 4 * lane;
#pragma unroll
        for (int e = 0; e < 4; ++e) { const LAS float* wp = wrl + ((gi * D + 256 * j + 64 * e + lane) * 8); const f32x4 w0 = *(const LAS f32x4*)wp, w1 = *(const LAS f32x4*)(wp + 4); const float hv = v[j][e]; (void)c;
            ev[0] += hv * w0.x; ev[1] += hv * w0.y; ev[2] += hv * w0.z; ev[3] += hv * w0.w; ev[4] += hv * w1.x; ev[5] += hv * w1.y; ev[6] += hv * w1.z; ev[7] += hv * w1.w; } }
#pragma unroll
    for (int i = 0; i < 8; ++i) ev[i] = wave_sum(ev[i], lane) + brt[gi * EPG + i];
    int j0 = 0; float v0 = ev[0];
#pragma unroll
    for (int i = 1; i < 8; ++i) if (ev[i] > v0) { v0 = ev[i]; j0 = i; }
    int j1 = -1; float v1 = -3.0e38f;
#pragma unroll
    for (int i = 0; i < 8; ++i) if (i != j0 && ev[i] > v1) { v1 = ev[i]; j1 = i; }
    if (lane == 0) {
        const float p1 = expf(v1 - v0), inv = 1.0f / (1.0f + p1); const int e0 = gi * EPG + j0, e1 = gi * EPG + j1;
        const int lp0 = __hip_atomic_fetch_add(lcnt + e0, 1, __ATOMIC_RELAXED, __HIP_MEMORY_SCOPE_WORKGROUP), lp1 = __hip_atomic_fetch_add(lcnt + e1, 1, __ATOMIC_RELAXED, __HIP_MEMORY_SCOPE_WORKGROUP);
        rec[0] = t; rec[1] = e0; rec[2] = lp0; rec[3] = e1; rec[4] = lp1;
        *(float2*)(tokgate + (size_t)t * 2) = make_float2(gw * inv, gw * p1 * inv);
    }
}
__device__ __forceinline__ void route_flush(int tl, int nrec_per_wave, LAS int* lcnt, LAS int* lbase, LAS int* recs, int* cnt, int* list, int cap, int* tokinfo) {
    __syncthreads();
    if (tl < NEXP) { const int n = lcnt[tl]; lbase[tl] = n ? atomicAdd(&cnt[tl * CNT_STRIDE], n) : 0; }
    __syncthreads();
    if (tl < 8 * nrec_per_wave) { const LAS int* r = recs + 8 * tl; const int t = r[0];
        if (t >= 0) { const int e0 = r[1], p0 = lbase[e0] + r[2], e1 = r[3], p1 = lbase[e1] + r[4];
            list[(size_t)e0 * cap + p0] = t; list[(size_t)e1 * cap + p1] = t; *(int4*)(tokinfo + (size_t)t * 4) = make_int4(e0, p0, e1, p1); } }
}
__device__ __forceinline__ void combine_ln2_wave(int t, int lane, const float* X1, float* X, const bf16_t* O, const LAS int* tst, const int* tokinfo, const float* tokgate, const float* MODl, const float* MODn,
                                                 const float* g2, const float* b2, float alpha, bf16_t* Hb, float* out, const Dims& dm) {
    const int b = t / dm.TPB, p = t % dm.TPB, row = p < CTX ? NB : b;
    const float* m = MODl + (size_t)row * NMOD * D + 5 * D; const float* xr = X1 + (size_t)t * D; float* xw = X + (size_t)t * D;
    const int4 ti = *(const int4*)(tokinfo + (size_t)t * 4); const float2 tg = *(const float2*)(tokgate + (size_t)t * 2);
    const bf16_t* o0 = O + ((size_t)256 * tst[ti.x] + ti.y) * D; const bf16_t* o1 = O + ((size_t)256 * tst[ti.z] + ti.w) * D;
    f32x4 v[4]; float s = 0.f;
#pragma unroll
    for (int j = 0; j < 4; ++j) { const int c = 256 * j + 4 * lane; const f32x4 f = tg.x * unpk4(*(const u32x2*)(o0 + c)) + tg.y * unpk4(*(const u32x2*)(o1 + c));
        v[j] = alpha * *(const f32x4*)(xr + c) + *(const f32x4*)(m + c) * f; s += hsum4(v[j]); }
    const float mean = wave_sum(s, lane) * (1.0f / D); float q = 0.f;
#pragma unroll
    for (int j = 0; j < 4; ++j) { v[j] = v[j] - mean; q += hsum4(v[j] * v[j]); }
    const float rstd = 1.0f / sqrtf(wave_sum(q, lane) * (1.0f / D) + LN_EPS);
#pragma unroll
    for (int j = 0; j < 4; ++j) { const int c = 256 * j + 4 * lane;
        const f32x4 xn = v[j] * rstd * *(const f32x4*)(g2 + c) + *(const f32x4*)(b2 + c); *(f32x4*)(xw + c) = xn;
        if (MODn) { const float* mn = MODn + (size_t)row * NMOD * D; *(u32x2*)(Hb + (size_t)t * D + c) = pk4(xn * (1.0f + *(const f32x4*)(mn + D + c)) + *(const f32x4*)(mn + c)); }
        else if (p >= CTX) *(f32x4*)(out + ((size_t)b * dm.S + (p - CTX)) * D + c) = xn; }
}
typedef short bf16x8_t __attribute__((ext_vector_type(8)));
__device__ __forceinline__ float bperm(int src_lane, float v) { return __int_as_float(__builtin_amdgcn_ds_bpermute(src_lane << 2, __float_as_int(v))); }
__device__ __forceinline__ float fast_sigmoid(float x) { return __builtin_amdgcn_rcpf(1.0f + __expf(-x)); }
__device__ __forceinline__ float gelu_fast(float x) { return x * fast_sigmoid(1.5957691216057308f * (x + 0.044715f * x * x * x)); }
constexpr int LRU_PITCH = 272;
constexpr int LRU_AT = 0, LRU_OH = 34816, LRU_OA = 69632;
template <int DIR>
__device__ __forceinline__ void lru_local_unit(int q, int blk, int tl, LAS unsigned char* lds, const bf16_t* P, const float* cw, const float* cb, const bf16_t* Wr_t, const float* br,
                                               const bf16_t* Wi_t, const float* bi, const float* cchp, bf16_t* HL, bf16_t* AC, float* SUMA, float* SUMH) {
    constexpr int CPB = Dims::TPB / CHUNK, NCH = Dims::T / CHUNK;
    const int b = q / CPB, cq = q % CPB, p0 = cq * CHUNK, seg_lo = cq < 2 ? 0 : CTX, seg_hi = cq < 2 ? CTX : Dims::TPB, ch0 = blk * LRU_BW;
    const int lane = tl & 63, w = tl >> 6, fr = lane & 15, fq = lane >> 4;
    const size_t tok0 = (size_t)b * Dims::TPB + p0;
    bf16x8_t wrf[4], wif[4];
    { const size_t wo = ((size_t)(DIR * 8 + blk) * LRU_BW + 16 * w + fr) * LRU_BW + 8 * fq;
#pragma unroll
      for (int ks = 0; ks < 4; ++ks) { wrf[ks] = *(const bf16x8_t*)(Wr_t + wo + 32 * ks); wif[ks] = *(const bf16x8_t*)(Wi_t + wo + 32 * ks); } }
    const int ch = ch0 + 16 * w + fr;
    const float cch = cchp[DIR * LRU_W + ch], brr = br[DIR * LRU_W + ch], bii = bi[DIR * LRU_W + ch];
    {
        const int cg = tl & 15, tg = tl >> 4, pb = p0 + 4 * tg - (DIR ? 0 : 3);
        float x[7][8]; v4u raw[7]; f32x4 w0[4], w1[4];
#pragma unroll
        for (int i = 0; i < 7; ++i) { const int p = pb + i; raw[i] = (v4u){0u, 0u, 0u, 0u};
            if (p >= seg_lo && p < seg_hi) raw[i] = *(const v4u*)(P + ((size_t)b * Dims::TPB + p) * IN_W + OFF_XR + ch0 + 8 * cg); }
#pragma unroll
        for (int j = 0; j < 4; ++j) { const float* wp = cw + (size_t)(DIR * 4 + j) * LRU_W + ch0 + 8 * cg; w0[j] = *(const f32x4*)wp; w1[j] = *(const f32x4*)(wp + 4); }
        const float* cbp = cb + DIR * LRU_W + ch0 + 8 * cg; const f32x4 c0 = *(const f32x4*)cbp, c1 = *(const f32x4*)(cbp + 4);
        __builtin_amdgcn_sched_barrier(0);
#pragma unroll
        for (int i = 0; i < 7; ++i)
#pragma unroll
            for (int e = 0; e < 4; ++e) { x[i][2 * e] = __uint_as_float(raw[i][e] << 16); x[i][2 * e + 1] = __uint_as_float(raw[i][e] & 0xffff0000u); }
        float wv[4][8], o[8];
#pragma unroll
        for (int j = 0; j < 4; ++j) { wv[j][0] = w0[j].x; wv[j][1] = w0[j].y; wv[j][2] = w0[j].z; wv[j][3] = w0[j].w; wv[j][4] = w1[j].x; wv[j][5] = w1[j].y; wv[j][6] = w1[j].z; wv[j][7] = w1[j].w; }
#pragma unroll
        for (int k = 0; k < 4; ++k) {
            o[0] = c0.x; o[1] = c0.y; o[2] = c0.z; o[3] = c0.w; o[4] = c1.x; o[5] = c1.y; o[6] = c1.z; o[7] = c1.w;
#pragma unroll
            for (int j = 0; j < 4; ++j)
#pragma unroll
                for (int e = 0; e < 8; ++e) o[e] += wv[j][e] * x[k + j][e];
            v4u pk; pk.x = pk2(o[0], o[1]); pk.y = pk2(o[2], o[3]); pk.z = pk2(o[4], o[5]); pk.w = pk2(o[6], o[7]);
            *(LAS v4u*)(lds + LRU_AT + (4 * tg + k) * LRU_PITCH + cg * 16) = pk; }
    }
    __syncthreads();
    f32x4 ar[8], ai[8];
#pragma unroll
    for (int m = 0; m < 8; ++m) { ar[m] = (f32x4){0.f, 0.f, 0.f, 0.f}; ai[m] = (f32x4){0.f, 0.f, 0.f, 0.f}; }
#pragma unroll
    for (int m = 0; m < 8; ++m)
#pragma unroll
        for (int ks = 0; ks < 4; ++ks) { const bf16x8_t a = *(const LAS bf16x8_t*)(lds + LRU_AT + (16 * m + fr) * LRU_PITCH + (32 * ks + 8 * fq) * 2);
            ar[m] = __builtin_amdgcn_mfma_f32_16x16x32_bf16(a, wrf[ks], ar[m], 0, 0, 0); ai[m] = __builtin_amdgcn_mfma_f32_16x16x32_bf16(a, wif[ks], ai[m], 0, 0, 0); }
#pragma unroll
    for (int m = 0; m < 8; ++m)
#pragma unroll
        for (int j = 0; j < 4; ++j) { const float tv = bf2f(*(const LAS bf16_t*)(lds + LRU_AT + (16 * m + 4 * fq + j) * LRU_PITCH + (16 * w + fr) * 2));
            const float r = fast_sigmoid(ar[m][j] + brr), ig = fast_sigmoid(ai[m][j] + bii), la = cch * r, xx = 2.0f * la;
            const float a = __expf(la); float omp = -xx * (1.0f + xx * (0.5f + xx * (0.16666667f + xx * (0.041666668f + xx * 0.0083333338f)))), omd = 1.0f - a * a;
            asm volatile("" : "+v"(omp), "+v"(omd));
            const float om = xx > -0.125f ? omp : omd;
            ar[m][j] = a; ai[m][j] = __builtin_amdgcn_sqrtf(om) * ig * tv; }
    const int rank = DIR ? 3 - fq : fq, src1 = DIR ? lane + 16 : lane - 16, src2 = DIR ? lane + 32 : lane - 32, srcT = DIR ? fr : fr + 48;
    float Ac = 1.f, Hc = 0.f;
#pragma unroll
    for (int mm = 0; mm < 8; ++mm) { constexpr int dummy = 0; (void)dummy; const int m = DIR ? 7 - mm : mm;
        float Al[4], Hl[4], A = 1.f, H = 0.f;
#pragma unroll
        for (int jj = 0; jj < 4; ++jj) { const int j = DIR ? 3 - jj : jj; H = ar[m][j] * H + ai[m][j]; A *= ar[m][j]; Al[j] = A; Hl[j] = H; }
        float Ai = A, Hi = H, Ap, Hp;
        Ap = bperm(src1, Ai); Hp = bperm(src1, Hi); if (rank >= 1) { Hi = Ai * Hp + Hi; Ai = Ap * Ai; }
        Ap = bperm(src2, Ai); Hp = bperm(src2, Hi); if (rank >= 2) { Hi = Ai * Hp + Hi; Ai = Ap * Ai; }
        float Ae = bperm(src1, Ai), He = bperm(src1, Hi); if (rank == 0) { Ae = 1.f; He = 0.f; }
        const float Ain = Ac * Ae, Hin = Ae * Hc + He;
        const float Am = bperm(srcT, Ai), Hm = bperm(srcT, Hi);
#pragma unroll
        for (int j = 0; j < 4; ++j) { const int off = (16 * m + 4 * fq + j) * LRU_PITCH + (16 * w + fr) * 2;
            *(LAS bf16_t*)(lds + LRU_OH + off) = f2bf(Al[j] * Hin + Hl[j]); *(LAS bf16_t*)(lds + LRU_OA + off) = f2bf(Ain * Al[j]); }
        Hc = Am * Hc + Hm; Ac = Ac * Am; }
    if (fq == 0) { SUMA[((size_t)DIR * NCH + q) * LRU_W + ch] = Ac; SUMH[((size_t)DIR * NCH + q) * LRU_W + ch] = Hc; }
    __syncthreads();
    {
        const int cg = tl & 15, tg = tl >> 4;
#pragma unroll
        for (int k = 0; k < 4; ++k) { const int row = 4 * tg + k; const size_t o = ((size_t)DIR * Dims::T + tok0 + row) * LRU_W + ch0 + 8 * cg;
            *(v4u*)(HL + o) = *(const LAS v4u*)(lds + LRU_OH + row * LRU_PITCH + cg * 16); *(v4u*)(AC + o) = *(const LAS v4u*)(lds + LRU_OA + row * LRU_PITCH + cg * 16); }
    }
    __syncthreads();
}
__device__ __forceinline__ void lru_carry_unit(int u, int tl, const float* SUMA, const float* SUMH, float* CARRY) {
    constexpr int CPB = Dims::TPB / CHUNK, NCH = Dims::T / CHUNK; constexpr int CB = 22; static_assert(CPB % CB == 0, "carry scan batches 22 chunks");
    const int b = u >> 2, dir = (u >> 1) & 1, ch = (u & 1) * 512 + tl; const size_t base = ((size_t)dir * NCH + (size_t)b * CPB) * LRU_W + ch;
    float c = 0.f;
    for (int i0 = 0; i0 < CPB; i0 += CB) { float a[CB], h[CB]; int kk[CB];
#pragma unroll
        for (int j = 0; j < CB; ++j) { const int i = i0 + j; kk[j] = dir ? (i == 0 ? 1 : (i == 1 ? 0 : CPB + 1 - i)) : i; a[j] = SUMA[base + (size_t)kk[j] * LRU_W]; h[j] = SUMH[base + (size_t)kk[j] * LRU_W]; }
#pragma unroll
        for (int j = 0; j < CB; ++j) { __hip_atomic_store(CARRY + base + (size_t)kk[j] * LRU_W, c, __ATOMIC_RELAXED, __HIP_MEMORY_SCOPE_AGENT); c = a[j] * c + h[j]; } }
}
__device__ __forceinline__ void lru_fix_rows(int t0, int nrows, int lane, const bf16_t* P, const bf16_t* HL, const bf16_t* AC, const float* CARRY, bf16_t* RO) {
    constexpr int NCH = Dims::T / CHUNK; const int ch0 = 16 * lane;
    float cf[16], cb[16]; int qc = -1;
    for (int r0 = 0; r0 < nrows; r0 += 3) {
        v4u h0[3][2], a0[3][2], h1[3][2], a1[3][2], zz[3][2];
#pragma unroll
        for (int i = 0; i < 3; ++i) { const int t = t0 + (r0 + i < nrows ? r0 + i : nrows - 1); const size_t o0 = (size_t)t * LRU_W + ch0, o1 = o0 + (size_t)Dims::T * LRU_W;
#pragma unroll
            for (int hq = 0; hq < 2; ++hq) { h0[i][hq] = *(const v4u*)(HL + o0 + 8 * hq); a0[i][hq] = *(const v4u*)(AC + o0 + 8 * hq); h1[i][hq] = *(const v4u*)(HL + o1 + 8 * hq); a1[i][hq] = *(const v4u*)(AC + o1 + 8 * hq);
                zz[i][hq] = *(const v4u*)(P + (size_t)t * IN_W + OFF_Z + ch0 + 8 * hq); } }
        __builtin_amdgcn_sched_barrier(0);
#pragma unroll
        for (int i = 0; i < 3; ++i) { if (r0 + i >= nrows) break; const int t = t0 + r0 + i, q = t >> 7;
            if (q != qc) { qc = q; const float* cfp = CARRY + (size_t)q * LRU_W + ch0; const float* cbp = cfp + (size_t)NCH * LRU_W;
#pragma unroll
                for (int k = 0; k < 4; ++k) { const f32x4 a = *(const f32x4*)(cfp + 4 * k), b = *(const f32x4*)(cbp + 4 * k);
                    cf[4 * k] = a.x; cf[4 * k + 1] = a.y; cf[4 * k + 2] = a.z; cf[4 * k + 3] = a.w; cb[4 * k] = b.x; cb[4 * k + 1] = b.y; cb[4 * k + 2] = b.z; cb[4 * k + 3] = b.w; } }
#pragma unroll
            for (int hq = 0; hq < 2; ++hq) { v4u o;
#pragma unroll
                for (int e = 0; e < 4; ++e) {
                    const float lo = (__uint_as_float(h0[i][hq][e] << 16) + __uint_as_float(a0[i][hq][e] << 16) * cf[8 * hq + 2 * e] + __uint_as_float(h1[i][hq][e] << 16) + __uint_as_float(a1[i][hq][e] << 16) * cb[8 * hq + 2 * e]) * __uint_as_float(zz[i][hq][e] << 16);
                    const float hi = (__uint_as_float(h0[i][hq][e] & 0xffff0000u) + __uint_as_float(a0[i][hq][e] & 0xffff0000u) * cf[8 * hq + 2 * e + 1] + __uint_as_float(h1[i][hq][e] & 0xffff0000u) + __uint_as_float(a1[i][hq][e] & 0xffff0000u) * cb[8 * hq + 2 * e + 1])
                                     * __uint_as_float(zz[i][hq][e] & 0xffff0000u);
                    o[e] = pk2(lo, hi); }
                *(v4u*)(RO + (size_t)t * ABR_LD + ch0 + 8 * hq) = o; } }
        __builtin_amdgcn_sched_barrier(0); }
}
struct EpiInProj {
    static constexpr bool PERM = true, AFTER_DRAIN = false, LDS_AUX = true;
    bf16_t* P; const float* bias; bf16_t* VT; const float* ROPE; LAS unsigned char* aux;
    __device__ __forceinline__ void aux_dma(const pg8::Unit& u, int par, int lane) const {
        __builtin_amdgcn_global_load_lds((const unsigned*)(bias + u.pn * 256 + lane * 4), (LAS unsigned*)(aux + par * 1024), 16, 0, 0);
        const int pr = u.pm % (Dims::TPB / 256), cb = pr ? 4 * (pr - 1) : 0;
        __builtin_amdgcn_global_load_lds((const unsigned*)(ROPE + ((lane & 16) ? 2048 : 0) + cb * 16 + (lane & 15) * 4), (LAS unsigned*)(aux + 2048 + par * 1024), 16, 0, 0);
    }
    __device__ __forceinline__ void operator()(const pg8::f32x4 (&acc)[2][2][4][2], const pg8::Unit& u, int wr, int wc, int fr, int fq, int par) const {
        const int lane = fq * 16 + fr, row0 = u.pm * 256 + wr * 64 + fr, bidx = u.pm / (Dims::TPB / 256); const bool ctxu = (u.pm % (Dims::TPB / 256)) == 0;
        const LAS float* bl = (const LAS float*)(aux + par * 1024); const LAS float* rr = (const LAS float*)(aux + 2048 + par * 1024); const LAS float* ct = (const LAS float*)(aux + 4096);
#pragma unroll
        for (int bj = 0; bj < 2; ++bj) {
            const int cbase = u.pn * 256 + bj * 128, cu = bj * 128 + wc * 32 + 8 * fq, col0 = u.pn * 256 + cu;
            const int mode = cbase < OFF_U ? 3 : cbase < OFF_G ? 1 : cbase < OFF_Z ? 0 : cbase < OFF_K ? 1 : cbase == OFF_K ? 3 : cbase == OFF_VAL ? 4 : 0;
            const f32x4 bv0 = *(const LAS f32x4*)(bl + cu), bv1 = *(const LAS f32x4*)(bl + cu + 4);
#pragma unroll
            for (int ai = 0; ai < 2; ++ai)
#pragma unroll
                for (int m = 0; m < 4; ++m) { const int row = row0 + ai * 128 + m * 16;
                    const f32x4 a0 = acc[ai][bj][m][0] + bv0, a1 = acc[ai][bj][m][1] + bv1;
                    float v[8] = {a0.x, a0.y, a0.z, a0.w, a1.x, a1.y, a1.z, a1.w};
                    if (mode == 1) {
#pragma unroll
                        for (int e = 0; e < 8; ++e) v[e] = gelu_fast(v[e]);
                    } else if (mode == 2) {
#pragma unroll
                        for (int e = 0; e < 8; ++e) v[e] = fast_sigmoid(v[e]);
                    } else if (mode == 3) {
                        if (!ctxu) {
                            const LAS float* cp = (wc & 1) ? ct + (16 * m + fr) * 16 + 8 * (fq & 1) : rr + (wr + 2 * ai) * 16 + 8 * (fq & 1); const int so = (wc & 1) ? 1024 : 64;
                            const f32x4 c0 = *(const LAS f32x4*)cp, c1 = *(const LAS f32x4*)(cp + 4), s0 = *(const LAS f32x4*)(cp + so), s1 = *(const LAS f32x4*)(cp + so + 4);
                            const float cs[8] = {c0.x, c0.y, c0.z, c0.w, c1.x, c1.y, c1.z, c1.w}, sn[8] = {s0.x, s0.y, s0.z, s0.w, s1.x, s1.y, s1.z, s1.w};
#pragma unroll
                            for (int e = 0; e < 8; ++e) { const float vp = bperm(lane ^ 32, v[e]); v[e] = v[e] * cs[e] + (fq < 2 ? -vp : vp) * sn[e]; } }
                        if (cbase < OFF_U) {
#pragma unroll
                            for (int e = 0; e < 8; ++e) v[e] *= QSCALE; }
                    } else if (mode == 4) { const int p = row - bidx * Dims::TPB; bf16_t* vt = VT + ((size_t)(bidx * NKV + (wc >> 1)) * HD + (wc & 1) * 32 + 8 * fq) * Dims::TPB + p;
#pragma unroll
                        for (int e = 0; e < 8; ++e) vt[(size_t)e * Dims::TPB] = f2bf(v[e]); }
                    pg8::u32x4 w4; w4.x = pg8::cvt_pk_bf16(v[0], v[1]); w4.y = pg8::cvt_pk_bf16(v[2], v[3]); w4.z = pg8::cvt_pk_bf16(v[4], v[5]); w4.w = pg8::cvt_pk_bf16(v[6], v[7]);
                    *(pg8::u32x4*)(P + (size_t)row * IN_W + col0) = w4; }
        }
    }
};
constexpr int ATT_KP = 144, ATT_VP = 528, ATT_K = 0, ATT_V = 256 * ATT_KP;
__device__ __forceinline__ void attn_unit(int u, int tl, LAS unsigned char* lds, const bf16_t* P, const bf16_t* VT, const float* sink, bf16_t* BO) {
    constexpr int CPB = Dims::TPB / CHUNK;
    int b, qb, kv;
    if (u < 2 * NB * (CPB - 2)) { kv = u & 1; const int jq = (u >> 1) % (CPB - 2); b = (u >> 1) / (CPB - 2); qb = jq + 2; } else { const int v_ = u - 2 * NB * (CPB - 2); kv = v_ & 1; qb = (v_ >> 1) & 1; b = v_ >> 2; }
    const int j = qb - 2;
    const int lane = tl & 63, w = tl >> 6, fr = lane & 15, fq = lane >> 4, hf = w & 1, h = kv * 4 + (w >> 1);
    const size_t trow0 = (size_t)b * Dims::TPB + (size_t)128 * qb;
    bf16x8_t qf[4][2];
#pragma unroll
    for (int nt = 0; nt < 4; ++nt)
#pragma unroll
        for (int ks = 0; ks < 2; ++ks) qf[nt][ks] = *(const bf16x8_t*)(P + (trow0 + 64 * hf + 16 * nt + fr) * IN_W + OFF_Q + h * HD + 32 * ks + 8 * fq);
    f32x4 o[4][4]; float mu[4], lp[4];
    const float sink2 = sink[h] * 1.4426950408889634f;
#pragma unroll
    for (int nt = 0; nt < 4; ++nt) { mu[nt] = sink2; lp[nt] = fq == 0 ? 1.0f : 0.0f;
#pragma unroll
        for (int dt = 0; dt < 4; ++dt) o[dt][nt] = (f32x4){0.f, 0.f, 0.f, 0.f}; }
    const int nstage = j < 0 ? 1 : (j == CPB - 3 ? 2 : 3);
    for (int st = 0; st < nstage; ++st) {
        const int kp0 = st == 0 ? 0 : (st == 1 ? 128 * qb - 128 : 128 * qb + 128), nk = st == 2 ? 128 : 256;
        __syncthreads();
        { const int row = tl >> 1, half = tl & 1;
          const bf16_t* src = P + ((size_t)b * Dims::TPB + kp0 + (row < nk ? row : 0)) * IN_W + OFF_K + kv * HD + half * 32;
          const int d = tl >> 3, seg = tl & 7; const bf16_t* vs = VT + ((size_t)(b * NKV + kv) * HD + d) * Dims::TPB + kp0;
          v4u kr[4], vr[4];
#pragma unroll
          for (int i = 0; i < 4; ++i) { kr[i] = *(const v4u*)(src + 8 * i); const int col = (seg + 8 * i) * 8; vr[i] = *(const v4u*)(vs + (col < nk ? col : 0)); }
          __builtin_amdgcn_sched_barrier(0);
          if (row < nk) {
#pragma unroll
              for (int i = 0; i < 4; ++i) *(LAS v4u*)(lds + ATT_K + row * ATT_KP + half * 64 + 16 * i) = kr[i]; }
#pragma unroll
          for (int i = 0; i < 4; ++i) { const int col = (seg + 8 * i) * 8; if (col < nk) *(LAS v4u*)(lds + ATT_V + d * ATT_VP + col * 2) = vr[i]; } }
        __syncthreads();
        const int hfu = __builtin_amdgcn_readfirstlane(hf);
        for (int kb = 0; kb < nk / 32; ++kb) {
            if (st == 1 && (32 * kb + 31 < 64 * hfu || (j == 0 && kb < 4))) continue;
            if (st == 2 && 32 * kb > 64 * hfu + 63) continue;
            f32x4 sc[2][4];
#pragma unroll
            for (int kt = 0; kt < 2; ++kt) { const bf16x8_t k0 = *(const LAS bf16x8_t*)(lds + ATT_K + (kb * 32 + 16 * kt + fr) * ATT_KP + 16 * fq), k1 = *(const LAS bf16x8_t*)(lds + ATT_K + (kb * 32 + 16 * kt + fr) * ATT_KP + 64 + 16 * fq);
#pragma unroll
                for (int nt = 0; nt < 4; ++nt) { sc[kt][nt] = __builtin_amdgcn_mfma_f32_16x16x32_bf16(k0, qf[nt][0], (f32x4){0.f, 0.f, 0.f, 0.f}, 0, 0, 0);
                    sc[kt][nt] = __builtin_amdgcn_mfma_f32_16x16x32_bf16(k1, qf[nt][1], sc[kt][nt], 0, 0, 0); } }
            if (st > 0) { const int dq = kb * 32 + 4 * fq - 64 * hf - fr, kq = kb * 32 + 4 * fq + (j > 0 ? 128 : 0);
                if (st == 1) {
#pragma unroll
                    for (int kt = 0; kt < 2; ++kt)
#pragma unroll
                        for (int nt = 0; nt < 4; ++nt)
#pragma unroll
                            for (int r = 0; r < 4; ++r) { const int c = 16 * kt + r - 16 * nt; const bool ok = (dq >= -c) & (kq >= 128 - 16 * kt - r); sc[kt][nt][r] = ok ? sc[kt][nt][r] : -1.0e30f; }
                } else {
#pragma unroll
                    for (int kt = 0; kt < 2; ++kt)
#pragma unroll
                        for (int nt = 0; nt < 4; ++nt)
#pragma unroll
                            for (int r = 0; r < 4; ++r) { const int c = 16 * kt + r - 16 * nt; sc[kt][nt][r] = (dq <= -c) ? sc[kt][nt][r] : -1.0e30f; }
                }
            }
            float mx[4]; bool need = false;
#pragma unroll
            for (int nt = 0; nt < 4; ++nt) { mx[nt] = fmaxf(fmaxf(fmaxf(sc[0][nt][0], sc[0][nt][1]), fmaxf(sc[0][nt][2], sc[0][nt][3])), fmaxf(fmaxf(sc[1][nt][0], sc[1][nt][1]), fmaxf(sc[1][nt][2], sc[1][nt][3])));
                need = need || (mx[nt] > mu[nt] + 8.0f); }
            if (__builtin_amdgcn_ballot_w64(need) != 0ull) {
#pragma unroll
                for (int nt = 0; nt < 4; ++nt) { float rm = fmaxf(mx[nt], bperm(lane ^ 16, mx[nt])); rm = fmaxf(rm, bperm(lane ^ 32, rm));
                    const float mn = fmaxf(mu[nt], rm), f = __builtin_amdgcn_exp2f(mu[nt] - mn); mu[nt] = mn; lp[nt] *= f;
#pragma unroll
                    for (int dt = 0; dt < 4; ++dt) o[dt][nt] = o[dt][nt] * f; }
            }
            bf16x8_t pf[4];
#pragma unroll
            for (int nt = 0; nt < 4; ++nt) { float pv[8];
#pragma unroll
                for (int e = 0; e < 8; ++e) { pv[e] = __builtin_amdgcn_exp2f(sc[e >> 2][nt][e & 3] - mu[nt]); }
                const unsigned w0 = pg8::cvt_pk_bf16(pv[0], pv[1]), w1 = pg8::cvt_pk_bf16(pv[2], pv[3]), w2 = pg8::cvt_pk_bf16(pv[4], pv[5]), w3 = pg8::cvt_pk_bf16(pv[6], pv[7]);
                lp[nt] += (__uint_as_float(w0 << 16) + __uint_as_float(w0 & 0xffff0000u)) + (__uint_as_float(w1 << 16) + __uint_as_float(w1 & 0xffff0000u))
                        + (__uint_as_float(w2 << 16) + __uint_as_float(w2 & 0xffff0000u)) + (__uint_as_float(w3 << 16) + __uint_as_float(w3 & 0xffff0000u));
                v4u pw; pw.x = w0; pw.y = w1; pw.z = w2; pw.w = w3; pf[nt] = __builtin_bit_cast(bf16x8_t, pw); }
#pragma unroll
            for (int dt = 0; dt < 4; ++dt) { const LAS unsigned char* vp = lds + ATT_V + (16 * dt + fr) * ATT_VP + (kb * 32 + 4 * fq) * 2;
                const u32x2 lo = *(const LAS u32x2*)vp, hi = *(const LAS u32x2*)(vp + 32); v4u vw; vw.x = lo.x; vw.y = lo.y; vw.z = hi.x; vw.w = hi.y; const bf16x8_t vf = __builtin_bit_cast(bf16x8_t, vw);
#pragma unroll
                for (int nt = 0; nt < 4; ++nt) o[dt][nt] = __builtin_amdgcn_mfma_f32_16x16x32_bf16(vf, pf[nt], o[dt][nt], 0, 0, 0); }
        }
    }
#pragma unroll
    for (int nt = 0; nt < 4; ++nt) { float l = lp[nt] + bperm(lane ^ 16, lp[nt]); l += bperm(lane ^ 32, l); const float inv = 1.0f / l;
        bf16_t* orow = BO + (trow0 + 64 * hf + 16 * nt + fr) * ABR_LD + h * HD + 4 * fq;
#pragma unroll
        for (int dt = 0; dt < 4; ++dt) { u32x2 w2_; w2_.x = pg8::cvt_pk_bf16(o[dt][nt][0] * inv, o[dt][nt][1] * inv); w2_.y = pg8::cvt_pk_bf16(o[dt][nt][2] * inv, o[dt][nt][3] * inv); *(u32x2*)(orow + 16 * dt) = w2_; } }
}
constexpr int SGU_PITCH = 272, SGU_T0 = 0, SGU_T1 = 34816, SGU_ST = 69632;
__device__ __forceinline__ void sgu_unit(int q, int pass0, int tl, LAS unsigned char* lds, const bf16_t* P, const float* lng, const float* lnb, const bf16_t* Wsp, const float* bsp, bf16_t* AO) {
    constexpr int CPB = Dims::TPB / CHUNK;
    const size_t t0 = (size_t)(q / CPB) * Dims::TPB + (size_t)(q % CPB) * CHUNK;
    const int lane = tl & 63, w = tl >> 6, fr = lane & 15, fq = lane >> 4;
    LAS float* stat = (LAS float*)(lds + SGU_ST);
    __syncthreads();
    {
        v4u raw[16]; float mean[16];
#pragma unroll
        for (int k = 0; k < 16; ++k) raw[k] = *(const v4u*)(P + (t0 + 16 * w + k) * IN_W + OFF_V + 8 * lane);
        __builtin_amdgcn_sched_barrier(0);
#pragma unroll
        for (int k = 0; k < 16; ++k) { float sm = 0.f;
#pragma unroll
            for (int e = 0; e < 4; ++e) sm += __uint_as_float(raw[k][e] << 16) + __uint_as_float(raw[k][e] & 0xffff0000u);
            mean[k] = wave_sum(sm, lane) * (1.0f / SGU_W); }
#pragma unroll
        for (int k = 0; k < 16; ++k) { float qq = 0.f;
#pragma unroll
            for (int e = 0; e < 4; ++e) { const float d0 = __uint_as_float(raw[k][e] << 16) - mean[k], d1 = __uint_as_float(raw[k][e] & 0xffff0000u) - mean[k]; qq += d0 * d0 + d1 * d1; }
            const float rstd = 1.0f / sqrtf(wave_sum(qq, lane) * (1.0f / SGU_W) + LN_EPS);
            if (lane == 0) { stat[2 * (16 * w + k)] = mean[k]; stat[2 * (16 * w + k) + 1] = rstd; } } }
    __syncthreads();
    { const int pass = pass0;
        {
            const int cg = tl & 15, qg = (tl >> 4) & 15, gs = tl >> 8, g = 2 * pass + gs; LAS unsigned char* tile = lds + (gs ? SGU_T1 : SGU_T0);
            const float* gp = lng + g * SGU_GW + 8 * cg; const float* bp = lnb + g * SGU_GW + 8 * cg;
            const f32x4 g0 = *(const f32x4*)gp, g1 = *(const f32x4*)(gp + 4), b0 = *(const f32x4*)bp, b1 = *(const f32x4*)(bp + 4);
            const float gg[8] = {g0.x, g0.y, g0.z, g0.w, g1.x, g1.y, g1.z, g1.w}, bb[8] = {b0.x, b0.y, b0.z, b0.w, b1.x, b1.y, b1.z, b1.w};
            float vn[8][8];
#pragma unroll
            for (int k = 0; k < 8; ++k) { const int tok = 8 * qg + k; const v4u raw = *(const v4u*)(P + (t0 + tok) * IN_W + OFF_V + g * SGU_GW + 8 * cg); const float mean = stat[2 * tok], rstd = stat[2 * tok + 1];
#pragma unroll
                for (int e = 0; e < 4; ++e) { vn[k][2 * e] = (__uint_as_float(raw[e] << 16) - mean) * rstd * gg[2 * e] + bb[2 * e]; vn[k][2 * e + 1] = (__uint_as_float(raw[e] & 0xffff0000u) - mean) * rstd * gg[2 * e + 1] + bb[2 * e + 1]; } }
#pragma unroll
            for (int e = 0; e < 8; ++e) { v4u pk; pk.x = pk2(vn[0][e], vn[1][e]); pk.y = pk2(vn[2][e], vn[3][e]); pk.z = pk2(vn[4][e], vn[5][e]); pk.w = pk2(vn[6][e], vn[7][e]);
                *(LAS v4u*)(tile + (8 * cg + e) * SGU_PITCH + qg * 16) = pk; }
        }
        __syncthreads();
        {
            const int gs = w >> 2, g = 2 * pass + gs, mt0 = 2 * (w & 3); const LAS unsigned char* tile = lds + (gs ? SGU_T1 : SGU_T0);
            bf16x8_t af[2][4];
#pragma unroll
            for (int mi = 0; mi < 2; ++mi)
#pragma unroll
                for (int ks = 0; ks < 4; ++ks) af[mi][ks] = *(const LAS bf16x8_t*)(tile + (16 * (mt0 + mi) + fr) * SGU_PITCH + (32 * ks + 8 * fq) * 2);
            const bf16_t* wg_ = Wsp + (size_t)g * CHUNK * CHUNK;
            u32x2 uu[8][2]; float bs[8];
#pragma unroll
            for (int nt = 0; nt < 8; ++nt) { const int p = 16 * nt + fr; bs[nt] = bsp[g * CHUNK + p];
#pragma unroll
                for (int mi = 0; mi < 2; ++mi) uu[nt][mi] = *(const u32x2*)(P + (t0 + p) * IN_W + OFF_U + g * SGU_GW + 16 * (mt0 + mi) + 4 * fq); }
#pragma unroll
            for (int nh = 0; nh < 2; ++nh) { bf16x8_t bfr[4][4];
#pragma unroll
                for (int n4 = 0; n4 < 4; ++n4)
#pragma unroll
                    for (int ks = 0; ks < 4; ++ks) bfr[n4][ks] = *(const bf16x8_t*)(wg_ + (size_t)(16 * (4 * nh + n4) + fr) * CHUNK + 32 * ks + 8 * fq);
                __builtin_amdgcn_sched_barrier(0);
#pragma unroll
                for (int n4 = 0; n4 < 4; ++n4) { const int nt = 4 * nh + n4; f32x4 acc0 = {0.f, 0.f, 0.f, 0.f}, acc1 = {0.f, 0.f, 0.f, 0.f};
#pragma unroll
                    for (int ks = 0; ks < 4; ++ks) { acc0 = __builtin_amdgcn_mfma_f32_16x16x32_bf16(af[0][ks], bfr[n4][ks], acc0, 0, 0, 0); acc1 = __builtin_amdgcn_mfma_f32_16x16x32_bf16(af[1][ks], bfr[n4][ks], acc1, 0, 0, 0); }
                    const size_t trow = t0 + 16 * nt + fr; const float b_ = bs[nt];
#pragma unroll
                    for (int mi = 0; mi < 2; ++mi) { const f32x4 a = mi ? acc1 : acc0; const int c = g * SGU_GW + 16 * (mt0 + mi) + 4 * fq; const f32x4 uf = unpk4(uu[nt][mi]);
                        u32x2 ow; ow.x = pk2(uf.x * (a.x + b_), uf.y * (a.y + b_)); ow.y = pk2(uf.z * (a.z + b_), uf.w * (a.w + b_)); *(u32x2*)(AO + trow * ABR_LD + c) = ow; } }
                __builtin_amdgcn_sched_barrier(0); }
        }
        __syncthreads();
    }
}
__device__ __forceinline__ void mod_unit(int u, int tl, LAS unsigned char* lds, const float* c, const float* c_ctx, const float* w_mod, const float* b_mod, float* MOD) {
    LAS float* sl = (LAS float*)lds; LAS float* part = (LAS float*)(lds + 16384);
    __syncthreads();
    for (int i = tl; i < 3 * D; i += 512) { const float v = i < 2 * D ? c[i] : c_ctx[i - 2 * D]; sl[i] = v / (1.0f + __expf(-v)); }
    __syncthreads();
    const int jl4 = tl & 31, kq = tl >> 5, l = u / (NMOD * D / 128), j = (u % (NMOD * D / 128)) * 128 + 4 * jl4;
    const float* w = w_mod + ((size_t)l * D + 64 * kq) * NMOD * D + j; f32x4 a0 = {0.f, 0.f, 0.f, 0.f}, a1 = a0, a2 = a0;
#pragma unroll 8
    for (int k = 0; k < 64; ++k) { const f32x4 wv = *(const f32x4*)(w + (size_t)k * NMOD * D); a0 += sl[64 * kq + k] * wv; a1 += sl[D + 64 * kq + k] * wv; a2 += sl[2 * D + 64 * kq + k] * wv; }
    *(LAS f32x4*)(part + (kq * 3 + 0) * 128 + 4 * jl4) = a0; *(LAS f32x4*)(part + (kq * 3 + 1) * 128 + 4 * jl4) = a1; *(LAS f32x4*)(part + (kq * 3 + 2) * 128 + 4 * jl4) = a2;
    __syncthreads();
    if (tl < 3 * 128) { const int r = tl >> 7, jl = tl & 127; float sum = 0.f;
#pragma unroll
        for (int q = 0; q < 16; ++q) sum += part[(q * 3 + r) * 128 + jl];
        MOD[((size_t)l * (NB + 1) + r) * NMOD * D + (u % (NMOD * D / 128)) * 128 + jl] = sum + b_mod[(size_t)l * NMOD * D + (u % (NMOD * D / 128)) * 128 + jl]; }
}
template <bool WT> __device__ __forceinline__ void merge8_t(size_t t, int c8, const bf16_t* P, const bf16_t* PS, bf16_t* Y);
__device__ __forceinline__ void merge8(size_t i, const bf16_t* P, const bf16_t* PS, bf16_t* Y) { merge8_t<false>(i >> 7, (int)(i & 127) * 8, P, PS, Y); }
struct M8 { v4u ga, gb, gr, p0, p1, p2, p3; };
__device__ __forceinline__ M8 merge8_load(size_t t, int c8, const bf16_t* P, const bf16_t* PS) {
    const bf16_t* g = P + t * IN_W + OFF_G + c8; const bf16_t* ps = PS + t * D + c8; constexpr size_t SS = (size_t)Dims::T * D;
    return M8{*(const v4u*)g, *(const v4u*)(g + D), *(const v4u*)(g + 2 * D), *(const v4u*)ps, *(const v4u*)(ps + SS), *(const v4u*)(ps + 2 * SS), *(const v4u*)(ps + 3 * SS)};
}
template <bool WT> __device__ __forceinline__ void merge8_fin(const M8& m8, size_t t, int c8, bf16_t* Y);
template <bool WT> __device__ __forceinline__ void merge8_t(size_t t, int c8, const bf16_t* P, const bf16_t* PS, bf16_t* Y) { const M8 m8 = merge8_load(t, c8, P, PS); merge8_fin<WT>(m8, t, c8, Y); }
template <bool WT> __device__ __forceinline__ void merge8_fin(const M8& m8, size_t t, int c8, bf16_t* Y) {
    const v4u ga = m8.ga, gb = m8.gb, gr = m8.gr, p0 = m8.p0, p1 = m8.p1, p2 = m8.p2, p3 = m8.p3;
    v4u o;
#pragma unroll
    for (int e = 0; e < 4; ++e) {
        const float lo = fast_sigmoid(__uint_as_float(ga[e] << 16)) * __uint_as_float(p0[e] << 16) + fast_sigmoid(__uint_as_float(gb[e] << 16)) * __uint_as_float(p1[e] << 16)
                       + fast_sigmoid(__uint_as_float(gr[e] << 16)) * (__uint_as_float(p2[e] << 16) + __uint_as_float(p3[e] << 16));
        const float hi = fast_sigmoid(__uint_as_float(ga[e] & 0xffff0000u)) * __uint_as_float(p0[e] & 0xffff0000u) + fast_sigmoid(__uint_as_float(gb[e] & 0xffff0000u)) * __uint_as_float(p1[e] & 0xffff0000u)
                       + fast_sigmoid(__uint_as_float(gr[e] & 0xffff0000u)) * (__uint_as_float(p2[e] & 0xffff0000u) + __uint_as_float(p3[e] & 0xffff0000u));
        o[e] = pk2(lo, hi); }
    if (WT) { unsigned long long* yp = (unsigned long long*)(Y + t * D + c8);
        __hip_atomic_store(yp, (unsigned long long)o.x | ((unsigned long long)o.y << 32), __ATOMIC_RELAXED, __HIP_MEMORY_SCOPE_AGENT);
        __hip_atomic_store(yp + 1, (unsigned long long)o.z | ((unsigned long long)o.w << 32), __ATOMIC_RELAXED, __HIP_MEMORY_SCOPE_AGENT); }
    else *(v4u*)(Y + t * D + c8) = o;
}
template <int CTRL> __device__ __forceinline__ float dpp_mov(float v) { return __int_as_float(__builtin_amdgcn_update_dpp(0, __float_as_int(v), CTRL, 0xf, 0xf, false)); }
__device__ __forceinline__ float row_sum16(float v) { v += dpp_mov<0x128>(v); v += dpp_mov<0x124>(v); v += dpp_mov<0x122>(v); v += dpp_mov<0x121>(v); return v; }
__device__ __forceinline__ void ln1_route_quad(int t, int lane, const float* X, const float* xin, const float* cin, float* X1, const float* YO, const float* MODl, const float* g1, const float* b1, float alpha, bf16_t* Hb,
                                               const float* wg, const float* bg, const LAS float* wrl, const float* brt, LAS int* lcnt, LAS int* rec, float* tokgate) {
    const int l16 = lane & 15, b = t / Dims::TPB, p = t % Dims::TPB, row = p < CTX ? NB : b;
    const float* m = MODl + (size_t)row * NMOD * D; float* xw = X1 + (size_t)t * D; const float* yr = YO + (size_t)t * D;
    const float* xr = xin ? (p < CTX ? cin + ((size_t)b * CTX + p) * D : xin + ((size_t)b * Dims::S + (p - CTX)) * D) : X + (size_t)t * D;
    f32x4 v[16]; float s = 0.f;
#pragma unroll
    for (int h = 0; h < 2; ++h) { f32x4 xa[8], ya[8], ma[8];
#pragma unroll
        for (int jj = 0; jj < 8; ++jj) { const int c = 64 * (8 * h + jj) + 4 * l16; xa[jj] = *(const f32x4*)(xr + c); ya[jj] = *(const f32x4*)(yr + c); ma[jj] = *(const f32x4*)(m + 2 * D + c); }
        __builtin_amdgcn_sched_barrier(0);
#pragma unroll
        for (int jj = 0; jj < 8; ++jj) { v[8 * h + jj] = alpha * xa[jj] + ma[jj] * ya[jj]; s += hsum4(v[8 * h + jj]); }
        __builtin_amdgcn_sched_barrier(0); }
    const float mean = row_sum16(s) * (1.0f / D); float q = 0.f;
#pragma unroll
    for (int j = 0; j < 16; ++j) { v[j] = v[j] - mean; q += hsum4(v[j] * v[j]); }
    const float rstd = 1.0f / sqrtf(row_sum16(q) * (1.0f / D) + LN_EPS);
    float gl[4] = {0.f, 0.f, 0.f, 0.f};
    f32x4 cg, cb, c4, c3;
    { const int c = 4 * l16; cg = *(const f32x4*)(g1 + c); cb = *(const f32x4*)(b1 + c); c4 = *(const f32x4*)(m + 4 * D + c); c3 = *(const f32x4*)(m + 3 * D + c); }
#pragma unroll
    for (int j = 0; j < 16; ++j) { const int c = 64 * j + 4 * l16, cn = c + 64;
        f32x4 ng = cg, nb = cb, n4 = c4, n3 = c3;
        if (j < 15) { ng = *(const f32x4*)(g1 + cn); nb = *(const f32x4*)(b1 + cn); n4 = *(const f32x4*)(m + 4 * D + cn); n3 = *(const f32x4*)(m + 3 * D + cn); }
        __builtin_amdgcn_sched_barrier(0);
        const f32x4 xn = v[j] * rstd * cg + cb; *(f32x4*)(xw + c) = xn;
        v[j] = xn * (1.0f + c4) + c3;
        *(u32x2*)(Hb + (size_t)t * D + c) = pk4(v[j]);
        __builtin_amdgcn_sched_barrier(0);
        cg = ng; cb = nb; c4 = n4; c3 = n3; }
#pragma unroll
    for (int h = 0; h < 4; ++h) { f32x4 wa[4][4];
#pragma unroll
        for (int jj = 0; jj < 4; ++jj)
#pragma unroll
            for (int e = 0; e < 4; ++e) wa[jj][e] = *(const f32x4*)(wg + (size_t)(64 * (4 * h + jj) + 4 * l16 + e) * NGRP);
        __builtin_amdgcn_sched_barrier(0);
#pragma unroll
        for (int jj = 0; jj < 4; ++jj)
#pragma unroll
            for (int e = 0; e < 4; ++e) { const f32x4 w = wa[jj][e]; const float hv = v[4 * h + jj][e]; gl[0] += hv * w.x; gl[1] += hv * w.y; gl[2] += hv * w.z; gl[3] += hv * w.w; }
        __builtin_amdgcn_sched_barrier(0); }
#pragma unroll
    for (int i = 0; i < 4; ++i) gl[i] = row_sum16(gl[i]) + bg[i];
    int gi = 0; float gm = gl[0]; if (gl[1] > gm) { gm = gl[1]; gi = 1; } if (gl[2] > gm) { gm = gl[2]; gi = 2; } if (gl[3] > gm) { gm = gl[3]; gi = 3; }
    const float gw = 1.0f / (expf(gl[0] - gm) + expf(gl[1] - gm) + expf(gl[2] - gm) + expf(gl[3] - gm));
    float ev[8] = {0.f, 0.f, 0.f, 0.f, 0.f, 0.f, 0.f, 0.f};
#pragma unroll
    for (int j = 0; j < 16; ++j)
#pragma unroll
        for (int e = 0; e < 4; ++e) { const LAS float* wp = wrl + ((gi * D + 64 * j + 16 * e + l16) * 4); const f32x4 w0 = *(const LAS f32x4*)wp, w1 = *(const LAS f32x4*)(wp + NGRP * D * 4); const float hv = v[j][e];
            ev[0] += hv * w0.x; ev[1] += hv * w0.y; ev[2] += hv * w0.z; ev[3] += hv * w0.w; ev[4] += hv * w1.x; ev[5] += hv * w1.y; ev[6] += hv * w1.z; ev[7] += hv * w1.w; }
#pragma unroll
    for (int i = 0; i < 8; ++i) ev[i] = row_sum16(ev[i]) + brt[gi * EPG + i];
    int j0 = 0; float v0 = ev[0];
#pragma unroll
    for (int i = 1; i < 8; ++i) if (ev[i] > v0) { v0 = ev[i]; j0 = i; }
    int j1 = -1; float v1 = -3.0e38f;
#pragma unroll
    for (int i = 0; i < 8; ++i) if (i != j0 && ev[i] > v1) { v1 = ev[i]; j1 = i; }
    if (l16 == 0) {
        const float p1 = expf(v1 - v0), inv = 1.0f / (1.0f + p1); const int e0 = gi * EPG + j0, e1 = gi * EPG + j1;
        const int lp0 = __hip_atomic_fetch_add(lcnt + e0, 1, __ATOMIC_RELAXED, __HIP_MEMORY_SCOPE_WORKGROUP), lp1 = __hip_atomic_fetch_add(lcnt + e1, 1, __ATOMIC_RELAXED, __HIP_MEMORY_SCOPE_WORKGROUP);
        rec[0] = t; rec[1] = e0; rec[2] = lp0; rec[3] = e1; rec[4] = lp1;
        *(float2*)(tokgate + (size_t)t * 2) = make_float2(gw * inv, gw * p1 * inv);
    }
}
__device__ __forceinline__ void combine_ln2_quad(int t, int lane, const float* X1, float* X, const bf16_t* O, const LAS int* tst, const int4 ti, const float2 tg, const LAS float* vec, bool has_next,
                                                 float alpha, bf16_t* Hb, float* out) {
    const int l16 = lane & 15, b = t / Dims::TPB, p = t % Dims::TPB, row = p < CTX ? NB : b;
    const LAS float* g2 = vec; const LAS float* b2 = vec + D; const LAS float* m = vec + 2 * D + row * 3 * D; const LAS float* mn = m + D;
    const float* xr = X1 + (size_t)t * D; float* xw = X + (size_t)t * D;
    const bf16_t* o0 = O + ((size_t)256 * tst[ti.x] + ti.y) * D; const bf16_t* o1 = O + ((size_t)256 * tst[ti.z] + ti.w) * D;
    f32x4 v[16]; float s = 0.f;
#pragma unroll
    for (int h = 0; h < 1; ++h) { f32x4 xa[16]; u32x2 oa[16], ob[16];
#pragma unroll
        for (int jj = 0; jj < 16; ++jj) { const int c = 64 * (16 * h + jj) + 4 * l16; xa[jj] = *(const f32x4*)(xr + c); oa[jj] = *(const u32x2*)(o0 + c); ob[jj] = *(const u32x2*)(o1 + c); }
        __builtin_amdgcn_sched_barrier(0);
#pragma unroll
        for (int jj = 0; jj < 16; ++jj) { const int j = 16 * h + jj, c = 64 * j + 4 * l16; const f32x4 f = tg.x * unpk4(oa[jj]) + tg.y * unpk4(ob[jj]);
            v[j] = alpha * xa[jj] + *(const LAS f32x4*)(m + c) * f; s += hsum4(v[j]); }
        __builtin_amdgcn_sched_barrier(0); }
    const float mean = row_sum16(s) * (1.0f / D); float q = 0.f;
#pragma unroll
    for (int j = 0; j < 16; ++j) { v[j] = v[j] - mean; q += hsum4(v[j] * v[j]); }
    const float rstd = __builtin_amdgcn_rsqf(row_sum16(q) * (1.0f / D) + LN_EPS);
#pragma unroll
    for (int j = 0; j < 16; ++j) { const int c = 64 * j + 4 * l16;
        const f32x4 xn = v[j] * rstd * *(const LAS f32x4*)(g2 + c) + *(const LAS f32x4*)(b2 + c);
        if (has_next) *(f32x4*)(xw + c) = xn;
        if (has_next) *(u32x2*)(Hb + (size_t)t * D + c) = pk4(xn * (1.0f + *(const LAS f32x4*)(mn + D + c)) + *(const LAS f32x4*)(mn + c));
        else if (p >= CTX) *(f32x4*)(out + ((size_t)b * Dims::S + (p - CTX)) * D + c) = xn; }
}
__device__ __forceinline__ void build_tst(const int* cnt, LAS int* tst, LAS int* cntl) {
    __syncthreads();
    const int tl = ltid();
    if (tl < 32) cntl[tl] = cnt[tl * CNT_STRIDE];
    __syncthreads();
    if (tl < 33) { int acc = 0; for (int e = 0; e < tl; ++e) acc += (cntl[e] + 255) / 256; tst[tl] = acc; }
    __syncthreads();
}
#endif

#ifdef CPU_SHIM
#define PROG_FN static void
#define DUP_BEGIN(k) { const int rep_ = 0; (void)rep_;
#define DUP_END }
#define PHASE_ARGS()
#define RUN_ITEMS(n, ...) cpu_items((size_t)(n), [&](size_t gi_) { __VA_ARGS__; })
#define GRID_SYNC() do { } while (0)
#define PROG_PARAMS const In& in, const Bufs& B, float* out, const Dims dm
#define GEMM_PHASE(EPI_T, EPI_ARGS, Ab, Wt, Wf32, M_, N_, K_, bias, Cf, Cb, ldc) RUN_ITEMS((size_t)(M_) * (N_), d_gemm_ref(gi_, Ab, K_, Wf32, N_, bias, Cf, Cb, ldc, N_, K_))
#else
typedef const __attribute__((address_space(4))) Args KArgs;
typedef const __attribute__((address_space(4))) In KIn;
typedef const __attribute__((address_space(4))) Bufs KBufs;
__device__ __forceinline__ KArgs* argp() { KArgs* p = (KArgs*)__builtin_amdgcn_kernarg_segment_ptr(); asm volatile("" : "+s"(p)); return p; }
#define PROG_FN __device__ __forceinline__ void
#ifndef PROBE_DUP
#define PROBE_DUP (-1)
#endif
#define DUP_BEGIN(k) for (int rep_ = 0; rep_ < ((k) == PROBE_DUP ? 2 : 1); ++rep_) {
#define DUP_END }
#if defined(PROBE_K1)
#define PROBE_STAMP() do { if (blockIdx.x == 0 && threadIdx.x == 0) { unsigned long long* ts_ = (unsigned long long*)(argp()->ws + 32768); const unsigned n_ = (unsigned)ts_[0]; ts_[1 + n_] = wall_clock64(); ts_[0] = n_ + 1; } } while (0)
#else
#define PROBE_STAMP() do { } while (0)
#endif
#define PHASE_ARGS() KArgs* A_ = argp(); KIn& in = A_->in; KBufs& B = A_->B; float* const out = A_->out; (void)in; (void)B; (void)out
#define RUN_ITEMS(n, ...) do { PHASE_ARGS(); const size_t g0_ = (size_t)blockIdx.x * 512 + ltid(), gstride = (size_t)NWG * 512; for (size_t gi_ = g0_; gi_ < (size_t)(n); gi_ += gstride) { __VA_ARGS__; } } while (0)
#define GRID_SYNC() do { XcdBarrier b_ = bar; b_.bar = (unsigned*)(argp()->ws + WS_CTL); { unsigned x_ = b_.x; asm volatile("" : "+s"(x_)); b_.x = x_; } xcd_barrier(b_); PROBE_STAMP(); } while (0)
#define PROG_PARAMS const Dims dm, const XcdBarrier& bar, LAS unsigned char* lds
#define GEMM_PHASE(EPI_T, EPI_ARGS, Ab, Wt, Wf32, M_, N_, K_, bias, Cf, Cb, ldc) do { PHASE_ARGS(); pg8::Gemm g_{Ab, Wt, M_, N_, K_}; pg8::StaticOrder S_; S_.init(M_, N_, NWG, (int)blockIdx.x); \
    const EPI_T E_ = pg8::mk<EPI_T> EPI_ARGS; pg8::gemm_phase(lds + RING_OFF, g_, S_, E_); } while (0)
#endif
#define GEMM_ITEMS(A, lda, arow, B, ldb, bstride, blk_e, bias, C, ldc, M, N, K) \
    RUN_ITEMS((size_t)((M) / 4) * ((N) / 4), d_gemm(gi_, A, lda, arow, B, ldb, bstride, blk_e, bias, C, ldc, M, N, K))

PROG_FN forward_program(PROG_PARAMS) {
    const size_t T = dm.T;
    const float ALPHA = sqrtf(sqrtf(2.0f * (float)dm.L));

    DUP_BEGIN(0)
#ifndef CPU_SHIM
    {
        PHASE_ARGS();
        const int tl = ltid(), lane = tl & 63, wave = tl >> 6, gw = blockIdx.x * 8 + wave, NGW = NWG * 8;
        LAS float* scr = (LAS float*)(lds + RING_OFF + wave * 16384);
        const int I_IN = (D / 64) * (IN_W / 32), I_A = (SGU_W / 64) * (D / 32), I_B = (ATT_W / 64) * (D / 32), I_C = (LRU_W / 64) * (D / 32), I_O = (D / 64) * (D / 32);
        const int per_l = I_IN + I_A + I_B + I_C + I_O;
        for (int it = gw; it < per_l * dm.L; it += NGW) {
            const int l = it / per_l; int r = it % per_l;
            if (r < I_IN) { p0_transpose_item(in.w_in + (size_t)l * D * IN_W, D, IN_W, B.Win_t + (size_t)l * IN_W * D, scr, r, lane); continue; } r -= I_IN;
            if (r < I_A) { p0_transpose_item_ld(in.w_proj_a + (size_t)l * SGU_W * D, SGU_W, D, B.Wabc_t + (size_t)l * D * ABR_LD, ABR_LD, scr, r, lane); continue; } r -= I_A;
            if (r < I_B) { p0_transpose_item_ld(in.w_proj_b + (size_t)l * ATT_W * D, ATT_W, D, B.Wabc_t + (size_t)l * D * ABR_LD + SGU_W, ABR_LD, scr, r, lane); continue; } r -= I_B;
            if (r < I_C) { p0_transpose_item_ld(in.w_proj_c + (size_t)l * LRU_W * D, LRU_W, D, B.Wabc_t + (size_t)l * D * ABR_LD + SGU_W + ATT_W, ABR_LD, scr, r, lane); continue; } r -= I_C;
            p0_transpose_item(in.w_out + (size_t)l * D * D, D, D, B.Wo_t + (size_t)l * D * D, scr, r, lane);
        }
        for (int it = gw; it < 2 * dm.L * 16 * 8; it += NGW) {
            const int gsel = it / (dm.L * 16 * 8), r = it % (dm.L * 16 * 8), mi = r / 8, ti = r % 8;
            p0_transpose_item((gsel ? in.w_igate : in.w_rgate) + (size_t)mi * LRU_BW * LRU_BW, LRU_BW, LRU_BW, (gsel ? B.Wi_t : B.Wr_t) + (size_t)mi * LRU_BW * LRU_BW, scr, ti, lane);
        }
    }
#endif
#ifdef CPU_SHIM
    RUN_ITEMS((size_t)dm.L * NMOD * D, d_mod(gi_, in.c, in.c_ctx, in.w_mod, in.b_mod, B.MOD, dm));
#else
    { PHASE_ARGS(); const int tl = ltid(); for (int u = (int)blockIdx.x; u < Dims::L * NMOD * D / 128; u += NWG) mod_unit(u, tl, lds, in.c, in.c_ctx, in.w_mod, in.b_mod, B.MOD); __syncthreads(); }
#endif
    RUN_ITEMS((size_t)dm.L * 2 * LRU_W, B.CCH[gi_] = -8.0f * softplus_neg(in.lru_lambda[gi_]));
    RUN_ITEMS(128 * 16, d_rope_table(gi_, B.ROPE));
#ifndef CPU_SHIM
    RUN_ITEMS((size_t)dm.L * 4 * CHUNK * CHUNK, B.Wsp_b[gi_] = f2bf(in.w_spatial[gi_]));
#endif
#ifdef CPU_SHIM
    RUN_ITEMS(T * D, d_init_x(gi_, in.x, in.ctx, B.X, dm));
#endif
    GRID_SYNC();
    DUP_END
    for (int l = 0; l < dm.L; ++l) {
        const bool lastl_ = (l + 1 == dm.L); (void)lastl_;
#ifdef CPU_SHIM
        if (l == 0) { RUN_ITEMS(T * D, d_modulate_bf(gi_, B.X, B.MOD, B.Hb, 0, dm)); GRID_SYNC(); }
#else
        if (l == 0) { PHASE_ARGS(); const size_t g0_ = (size_t)blockIdx.x * 512 + ltid(), gs_ = (size_t)NWG * 512, n_ = T * (D / 4);
            for (size_t gi0 = g0_; gi0 < n_; gi0 += 4 * gs_) { f32x4 xv[4], ms[4], mh[4];
#pragma unroll
                for (int u_ = 0; u_ < 4; ++u_) { const size_t gi_ = gi0 + u_ * gs_ < n_ ? gi0 + u_ * gs_ : g0_;
                    const int t_ = (int)(gi_ >> 8), c_ = (int)(gi_ & 255) * 4, b_ = t_ / Dims::TPB, p_ = t_ % Dims::TPB; const float* m_ = B.MOD + (size_t)(p_ < CTX ? NB : b_) * NMOD * D;
                    xv[u_] = *(const f32x4*)((p_ < CTX ? in.ctx + ((size_t)b_ * CTX + p_) * D : in.x + ((size_t)b_ * Dims::S + (p_ - CTX)) * D) + c_); ms[u_] = *(const f32x4*)(m_ + D + c_); mh[u_] = *(const f32x4*)(m_ + c_); }
                __builtin_amdgcn_sched_barrier(0);
#pragma unroll
                for (int u_ = 0; u_ < 4; ++u_) { const size_t gi_ = gi0 + u_ * gs_; if (gi_ < n_) *(u32x2*)(B.Hb + (gi_ >> 8) * D + (gi_ & 255) * 4) = pk4(xv[u_] * (1.0f + ms[u_]) + mh[u_]); } }
            GRID_SYNC(); }
#endif
        DUP_BEGIN(1)
#ifdef CPU_SHIM
        GEMM_PHASE(pg8::EpiBf16, (B.P, IN_W, in.b_in + (size_t)l * IN_W, 0x7fffffff, (size_t)0), B.Hb, B.Win_t + (size_t)l * IN_W * D, in.w_in + (size_t)l * D * IN_W, (int)T, IN_W, D,
                   in.b_in + (size_t)l * IN_W, (float*)nullptr, B.P, IN_W);
        RUN_ITEMS(T * (IN_W / 2), d_inproj_act(gi_, B.P, B.VT, B.ROPE, dm));
#else
        { PHASE_ARGS(); const int tl = ltid();
          *(LAS f32x4*)(lds + MISC_OFF + 1024 + 4096 + tl * 16) = *(const f32x4*)((const float*)B.ROPE + (tl >> 8) * 2048 + (tl & 255) * 4); __syncthreads(); }
        GEMM_PHASE(EpiInProj, (B.P, in.b_in + (size_t)l * IN_W, B.VT, (const float*)B.ROPE, lds + MISC_OFF + 1024), B.Hb, B.Win_t + (size_t)l * IN_W * D, in.w_in + (size_t)l * D * IN_W, (int)T, IN_W, D,
                   in.b_in + (size_t)l * IN_W, (float*)nullptr, B.P, IN_W);
#endif
        GRID_SYNC();
        DUP_END
        DUP_BEGIN(3)
        {
            PHASE_ARGS();
            const float* cwl = in.conv_w + (size_t)l * 2 * 4 * LRU_W; const float* cbl = in.conv_b + l * 2 * LRU_W; const float* brl = in.b_rgate + l * 2 * LRU_W; const float* bil = in.b_igate + l * 2 * LRU_W;
            const float* lml = B.CCH + l * 2 * LRU_W;
#ifdef CPU_SHIM
            RUN_ITEMS((size_t)2 * (T / CHUNK) * LRU_W, d_lru_local_ref(gi_, B.P, cwl, cbl, in.w_rgate + (size_t)l * 2 * 8 * LRU_BW * LRU_BW, brl, in.w_igate + (size_t)l * 2 * 8 * LRU_BW * LRU_BW, bil, lml,
                      B.HL, B.AC, B.SUMA, B.SUMH, dm));
#else
            const int tl = ltid(); const bf16_t* wrt_ = B.Wr_t + (size_t)l * 2 * 8 * LRU_BW * LRU_BW; const bf16_t* wit_ = B.Wi_t + (size_t)l * 2 * 8 * LRU_BW * LRU_BW;
            static_assert(3 * NEXP * 256 == 16 * (NWG - 64) * 8 && (Dims::T / CHUNK) * 16 == 8 * NWG + 64, "conversion share: 16 tiles per wave of workgroups 64..255");
            int k_ = 0;
            for (int u = (int)blockIdx.x; u < (Dims::T / CHUNK) * 16; u += NWG, ++k_) {
                if ((int)blockIdx.x >= 64 && k_ == (((int)blockIdx.x >> 3) & 7)) {
                    __syncthreads();
                    const int lane = tl & 63, wave = tl >> 6; LAS float* scr = (LAS float*)(lds + RING_OFF + wave * 16384); const size_t ws1 = (size_t)D * DEXP * NEXP; constexpr int NCW = (NWG - 64) * 8;
                    for (int it = ((int)blockIdx.x - 64) * 8 + wave; it < 3 * NEXP * 256; it += 2 * NCW) {
                        const TileSrc ta = moe_weight_tile(in.w1 + (size_t)l * ws1, in.w3 + (size_t)l * ws1, in.w2 + (size_t)l * ws1, B.W13_t, B.W2_t, it);
                        const TileSrc tb = moe_weight_tile(in.w1 + (size_t)l * ws1, in.w3 + (size_t)l * ws1, in.w2 + (size_t)l * ws1, B.W13_t, B.W2_t, it + NCW);
                        f32x4 va[8], vb[8]; tile_load(ta, lane, va); tile_load(tb, lane, vb); tile_store(ta, lane, va, scr); tile_store(tb, lane, vb, scr); }
                    __syncthreads();
                }
                if (u & 1) lru_local_unit<1>(u >> 4, (u >> 1) & 7, tl, lds, B.P, cwl, cbl, wrt_, brl, wit_, bil, lml, B.HL, B.AC, B.SUMA, B.SUMH);
                else       lru_local_unit<0>(u >> 4, (u >> 1) & 7, tl, lds, B.P, cwl, cbl, wrt_, brl, wit_, bil, lml, B.HL, B.AC, B.SUMA, B.SUMH);
            }
#endif
        }
        GRID_SYNC();
        DUP_END
        DUP_BEGIN(2)
#ifdef CPU_SHIM
        RUN_ITEMS(T, d_sgu_ln(gi_, B.P, in.sgu_ln_g + l * SGU_W, in.sgu_ln_b + l * SGU_W, B.VN, dm));
        RUN_ITEMS(T * SGU_W, d_sgu_mix(gi_, B.P, B.VN, in.w_spatial + (size_t)l * 4 * CHUNK * CHUNK, in.b_spatial + l * 4 * CHUNK, B.AO, dm));
#else
        { PHASE_ARGS(); const int tl = ltid();
          if ((int)blockIdx.x >= 8 && (int)blockIdx.x < 16) { lru_carry_unit((int)blockIdx.x - 8, tl, B.SUMA, B.SUMH, B.CARRY);
              asm volatile("s_waitcnt vmcnt(0)" ::: "memory"); __syncthreads();
              if (tl == 0) __hip_atomic_fetch_add((unsigned*)(A_->ws + WS_CARRYFLAG), 1u, __ATOMIC_RELAXED, __HIP_MEMORY_SCOPE_AGENT); } }
        { PHASE_ARGS(); const int tl = ltid();
          for (int u = NWG - 1 - (int)blockIdx.x; u < 2 * (Dims::T / CHUNK); u += NWG) {
              if (lastl_ && (u >> 1) % (Dims::TPB / CHUNK) < 2) continue;
              sgu_unit(u >> 1, u & 1, tl, lds, B.P, in.sgu_ln_g + l * SGU_W, in.sgu_ln_b + l * SGU_W, B.Wsp_b + (size_t)l * 4 * CHUNK * CHUNK, in.b_spatial + l * 4 * CHUNK, B.AO); } }
#endif
#ifdef CPU_SHIM
        RUN_ITEMS(T * NH, d_attn_ref(gi_, B.P, B.VT, in.attn_sink + l * NH, B.BO, dm));
#else
        { const bool fixfirst = (((int)blockIdx.x >> 3) & 1) && !((int)blockIdx.x >= 8 && (int)blockIdx.x < 16);
          for (int step = 0; step < 2; ++step) {
            if ((step == 0) != fixfirst) {
              PHASE_ARGS(); const int tl = ltid(); __syncthreads();
              for (int u = (int)blockIdx.x; u < (lastl_ ? 2 * NB * (Dims::TPB / CHUNK - 2) : 2 * NB * (Dims::TPB / CHUNK)); u += NWG) attn_unit(u, tl, lds, B.P, B.VT, in.attn_sink + l * NH, B.BO);
            } else {
              PHASE_ARGS(); const int tl = ltid();
              if (tl == 0) { unsigned* fl = (unsigned*)(A_->ws + WS_CARRYFLAG); unsigned* tmo = (unsigned*)(A_->ws + WS_CTL) + XB_TMO; const unsigned need = 8u * (unsigned)(l + 1); unsigned sp = 0;
                  while (__hip_atomic_load(fl, __ATOMIC_RELAXED, __HIP_MEMORY_SCOPE_AGENT) < need) { __builtin_amdgcn_s_sleep(2);
                      if ((++sp & 255u) == 0u) { if (xb_ld(tmo)) break; if (sp > XB_SPIN_CAP) { atomicAdd(tmo, 1u); break; } } }
                  __builtin_amdgcn_fence(__ATOMIC_ACQUIRE, "agent"); asm volatile("s_waitcnt vmcnt(0)" ::: "memory"); }
              __syncthreads();
              { constexpr int NR = (Dims::T + NWG * 8 - 1) / (NWG * 8); const int t0 = ((int)blockIdx.x * 8 + (tl >> 6)) * NR;
                if (t0 < (int)T) lru_fix_rows(t0, (int)T - t0 < NR ? (int)T - t0 : NR, tl & 63, B.P, B.HL, B.AC, B.CARRY, B.RO); }
            } } }
#endif
        GRID_SYNC();
        DUP_END
        DUP_BEGIN(4)
#ifdef CPU_SHIM
        RUN_ITEMS(T * LRU_W, d_lru_fix_ref(gi_, B.P, B.HL, B.AC, B.SUMA, B.SUMH, B.RO, dm));
#endif
        DUP_END
        DUP_BEGIN(5)
#ifdef CPU_SHIM
        RUN_ITEMS(T * D, d_gemm_ref(gi_, B.AO, ABR_LD, in.w_proj_a + (size_t)l * SGU_W * D, D, (const float*)nullptr, B.PA, (bf16_t*)nullptr, D, D, SGU_W));
        RUN_ITEMS(T * D, d_gemm_ref(gi_, B.BO, ABR_LD, in.w_proj_b + (size_t)l * ATT_W * D, D, (const float*)nullptr, B.PB, (bf16_t*)nullptr, D, D, ATT_W));
        RUN_ITEMS(T * D, d_gemm_ref(gi_, B.RO, ABR_LD, in.w_proj_c + (size_t)l * LRU_W * D, D, (const float*)nullptr, B.PC, (bf16_t*)nullptr, D, D, LRU_W));
#else
        { PHASE_ARGS(); const pg8::Gemm g_{B.AO, B.Wabc_t + (size_t)l * D * ABR_LD, (int)T, D, 512, ABR_LD, ABR_LD};
          const pg8::EpiBf16 E_{B.PS, D, nullptr, 0x7fffffff, (size_t)T * D};
          if (lastl_) { const pg8::LatentSliceOrder S_{NWG, (int)blockIdx.x, 2}; pg8::gemm_phase<pg8::EpiBf16, pg8::LatentSliceOrder, false>(lds + RING_OFF, g_, S_, E_); }
          else { pg8::SliceOrder S_; S_.T4.init((int)T, D, 1, 0); S_.G = NWG; S_.c = (int)blockIdx.x; pg8::gemm_phase<pg8::EpiBf16, pg8::SliceOrder, false>(lds + RING_OFF, g_, S_, E_); } }
#endif
        RUN_ITEMS(NEXP, B.cnt[gi_ * CNT_STRIDE] = 0);
        GRID_SYNC();
        DUP_END
        DUP_BEGIN(6)
#ifdef CPU_SHIM
        RUN_ITEMS(T * D, d_merge(gi_, B.P, B.PA, B.PB, B.PC, B.Y, dm));
#else
        if (lastl_) { PHASE_ARGS(); const size_t g0_ = (size_t)blockIdx.x * 512 + ltid(), gs_ = (size_t)NWG * 512, n_ = T * (D / 8);
            for (size_t ia = g0_; ia < n_; ia += 2 * gs_) { const size_t ib = ia + gs_ < n_ ? ia + gs_ : ia;
                const M8 ma_ = merge8_load(ia >> 7, (int)(ia & 127) * 8, B.P, B.PS), mb_ = merge8_load(ib >> 7, (int)(ib & 127) * 8, B.P, B.PS);
                __builtin_amdgcn_sched_barrier(0);
                merge8_fin<false>(ma_, ia >> 7, (int)(ia & 127) * 8, B.Y); if (ib != ia) merge8_fin<false>(mb_, ib >> 7, (int)(ib & 127) * 8, B.Y); } }
        else { PHASE_ARGS(); const int tl = ltid(); constexpr int TB256 = Dims::TPB / 256;
            for (int it = (int)blockIdx.x * 512 + tl; it < NB * CTX * (D / 8); it += NWG * 512) { const int r = it >> 7; merge8_t<true>((size_t)(r >> 8) * Dims::TPB + (r & 255), (it & 127) * 8, B.P, B.PS, B.Y); }
            asm volatile("s_waitcnt vmcnt(0)" ::: "memory"); __syncthreads();
            if (tl == 0) __hip_atomic_fetch_add((unsigned*)(A_->ws + WS_YCTXFLAG), 1u, __ATOMIC_RELAXED, __HIP_MEMORY_SCOPE_AGENT);
            if ((int)blockIdx.x < 8) {
                if (tl == 0) { unsigned* fl = (unsigned*)(A_->ws + WS_YCTXFLAG); unsigned* tmo = (unsigned*)(A_->ws + WS_CTL) + XB_TMO; const unsigned need = (unsigned)NWG * (unsigned)(l + 1); unsigned sp = 0;
                    while (__hip_atomic_load(fl, __ATOMIC_RELAXED, __HIP_MEMORY_SCOPE_AGENT) < need) { __builtin_amdgcn_s_sleep(2);
                        if ((++sp & 255u) == 0u) { if (xb_ld(tmo)) break; if (sp > XB_SPIN_CAP) { atomicAdd(tmo, 1u); break; } } }
                    __builtin_amdgcn_fence(__ATOMIC_ACQUIRE, "agent"); asm volatile("s_waitcnt vmcnt(0)" ::: "memory"); }
                __syncthreads();
                const pg8::Gemm g_{B.Y, B.Wo_t + (size_t)l * D * D, (int)T, D, D, 0, 0}; const pg8::OneTileOrder S_{((int)blockIdx.x >> 2) * TB256, (int)blockIdx.x & 3}; const pg8::EpiF32 E_{B.YO, D, in.b_out + l * D};
                pg8::gemm_phase<pg8::EpiF32, pg8::OneTileOrder, false>(lds + RING_OFF, g_, S_, E_);
            } else {
                constexpr size_t n_ = (size_t)NB * Dims::S * (D / 8), gs_ = (size_t)(NWG - 8) * 512;
                for (size_t ia = (size_t)((int)blockIdx.x - 8) * 512 + tl; ia < n_; ia += 2 * gs_) { const size_t ib = ia + gs_ < n_ ? ia + gs_ : ia, ra = ia >> 7, rb = ib >> 7;
                    const size_t ta = (ra / Dims::S) * Dims::TPB + CTX + (ra % Dims::S), tb = (rb / Dims::S) * Dims::TPB + CTX + (rb % Dims::S);
                    const M8 ma_ = merge8_load(ta, (int)(ia & 127) * 8, B.P, B.PS), mb_ = merge8_load(tb, (int)(ib & 127) * 8, B.P, B.PS);
                    __builtin_amdgcn_sched_barrier(0);
                    merge8_fin<false>(ma_, ta, (int)(ia & 127) * 8, B.Y); if (ib != ia) merge8_fin<false>(mb_, tb, (int)(ib & 127) * 8, B.Y); } }
        }
#endif
        GRID_SYNC();
        DUP_END
        DUP_BEGIN(7)
#ifndef CPU_SHIM
        if (lastl_) { PHASE_ARGS(); const pg8::Gemm g_{B.Y, B.Wo_t + (size_t)l * D * D, (int)T, D, D, 0, 0}; const pg8::LatentSliceOrder S_{NWG, (int)blockIdx.x, 0}; const pg8::EpiF32 E_{B.YO, D, in.b_out + l * D};
            pg8::gemm_phase<pg8::EpiF32, pg8::LatentSliceOrder, false>(lds + RING_OFF, g_, S_, E_); }
        else { PHASE_ARGS(); const pg8::Gemm g_{B.Y, B.Wo_t + (size_t)l * D * D, (int)T, D, D, 0, 0}; const pg8::LatentSliceOrder S_{NWG, (int)blockIdx.x, 0}; const pg8::EpiF32 E_{B.YO, D, in.b_out + l * D};
            pg8::gemm_phase<pg8::EpiF32, pg8::LatentSliceOrder, false>(lds + RING_OFF, g_, S_, E_); }
#else
        GEMM_PHASE(pg8::EpiF32, (B.YO, D, in.b_out + l * D), B.Y, B.Wo_t + (size_t)l * D * D, in.w_out + (size_t)l * D * D, (int)T, D, D, in.b_out + l * D, B.YO, (bf16_t*)nullptr, D);
#endif
        GRID_SYNC();
        DUP_END
        DUP_BEGIN(8)
        if (rep_ == 1) { RUN_ITEMS(NEXP, B.cnt[gi_ * CNT_STRIDE] = 0); GRID_SYNC(); }
        DBG_DUMP("YO", l, B.YO, T * D);
        {
            PHASE_ARGS();
            const int cap = (int)T * 2; const bool lastl = (l + 1 == dm.L);
            float* const Xp = B.X; const float* const MODc = B.MOD + (size_t)l * (NB + 1) * NMOD * D; (void)lastl;
#ifdef CPU_SHIM
            RUN_ITEMS(T, d_ln1_route(gi_, Xp, B.H, B.YO, MODc, in.ln1_g + l * D, in.ln1_b + l * D, ALPHA, B.Hb, in.w_group + (size_t)l * D * NGRP, in.b_group + l * NGRP,
                      in.w_router + (size_t)l * D * NEXP, in.b_router + l * NEXP, B.cnt, B.list, cap, B.tokinfo, B.tokgate, dm));
#else
            const int tl = ltid(); constexpr int NQ = Dims::T / 4, NREC = 4 * ((NQ + NWG * 8 - 1) / (NWG * 8));
            LAS int* lcnt = (LAS int*)(lds + MISC_OFF + 1024); LAS int* lbase = lcnt + 32; LAS int* recs = lcnt + 64;
            LAS float* wrl = (LAS float*)(lds + RING_OFF);
            __syncthreads();
            if (tl < 32) lcnt[tl] = 0;
            if (tl < 8 * NREC) recs[8 * tl] = -1;
            { const float* wsrc = in.w_router + (size_t)l * D * NEXP;
              static_assert(D * NGRP == 8 * 512, "8 (row, group) pairs per thread");
              f32x4 a[8], bq[8];
#pragma unroll
              for (int it = 0; it < 8; ++it) { const int i = tl + 512 * it, k = i >> 2, g = i & 3; a[it] = *(const f32x4*)(wsrc + (size_t)k * NEXP + g * EPG); bq[it] = *(const f32x4*)(wsrc + (size_t)k * NEXP + g * EPG + 4); }
              __builtin_amdgcn_sched_barrier(0);
#pragma unroll
              for (int it = 0; it < 8; ++it) { const int i = tl + 512 * it, k = i >> 2, g = i & 3, slot = (k & ~63) + 16 * (k & 3) + ((k & 63) >> 2);
                  LAS float* dp = wrl + (g * D + slot) * 4; *(LAS f32x4*)dp = a[it]; *(LAS f32x4*)(dp + NGRP * D * 4) = bq[it]; } }
            __syncthreads();
            static_assert(NQ == 2 * NWG * 8 + NWG / 2, "two quads per wave + 128 left over: those go to wave 0 of workgroups 0..127 (one per CU) instead of all eight waves of 16 workgroups");
            { for (int i = 0; i < 3; ++i) { const int qd = i < 2 ? (int)(blockIdx.x * 8 + (tl >> 6)) + i * NWG * 8 : ((tl >> 6) == 0 && (int)blockIdx.x < NWG / 2 ? 2 * NWG * 8 + (int)blockIdx.x : NQ);
                if (qd >= NQ) break;
                ln1_route_quad(4 * qd + ((tl & 63) >> 4), tl & 63, Xp, l == 0 ? in.x : (const float*)nullptr, in.ctx, B.H, B.YO, MODc, in.ln1_g + l * D, in.ln1_b + l * D, ALPHA, B.Hb, in.w_group + (size_t)l * D * NGRP, in.b_group + l * NGRP,
                               wrl, in.b_router + l * NEXP, lcnt, recs + 8 * ((tl >> 6) * NREC + 4 * i + ((tl & 63) >> 4)), B.tokgate); } }
            route_flush(tl, NREC, lcnt, lbase, recs, B.cnt, B.list, cap, B.tokinfo);
#endif
        }
        GRID_SYNC();
        DUP_END
        DUP_BEGIN(9)
        {
            PHASE_ARGS();
            const int cap = (int)T * 2; const size_t ws1 = (size_t)D * DEXP;
#ifdef CPU_SHIM
            d_moe_tst(B.cnt, B.tst);
            RUN_ITEMS((size_t)B.tst[NEXP] * 256 * DEXP, d_moe1_ref(gi_, B.Hb, in.w1 + (size_t)l * NEXP * ws1, in.w3 + (size_t)l * NEXP * ws1, B.cnt, B.tst, B.list, cap, B.HHb));
#else
            (void)ws1;
            LAS int* tst = (LAS int*)(lds + MISC_OFF + 64); LAS int* cntl = (LAS int*)(lds + MISC_OFF + 256);
            build_tst(B.cnt, tst, cntl);
            const pg8::MoeOrder S_{tst, cntl, B.list, cap, NWG, (int)blockIdx.x};
            const pg8::Gemm g_{B.Hb, B.W13_t, 0, 0, D}; const pg8::EpiSwiglu E_{B.HHb, DEXP};
            pg8::gemm_phase<pg8::EpiSwiglu, pg8::MoeOrder, true>(lds + RING_OFF, g_, S_, E_);
#endif
        }
        GRID_SYNC();
        DUP_END
        DUP_BEGIN(10)
        {
            PHASE_ARGS();
#ifdef CPU_SHIM
            RUN_ITEMS((size_t)B.tst[NEXP] * 256 * D, d_moe2_ref(gi_, B.HHb, in.w2 + (size_t)l * NEXP * D * DEXP, B.tst, B.Ob));
#else
            LAS int* tst = (LAS int*)(lds + MISC_OFF + 64); LAS int* cntl = (LAS int*)(lds + MISC_OFF + 256);
            const pg8::MoeOrder S_{tst, cntl, B.list, (int)T * 2, NWG, (int)blockIdx.x};
            const pg8::Gemm g_{B.HHb, B.W2_t, 0, 0, DEXP}; const pg8::EpiBf16 E_{B.Ob, D, nullptr, 3, 0};
            pg8::gemm_phase<pg8::EpiBf16, pg8::MoeOrder, false>(lds + RING_OFF, g_, S_, E_);
#endif
        }
        GRID_SYNC();
        DUP_END
        DUP_BEGIN(11)
        {
            PHASE_ARGS();
            const bool lastl = (l + 1 == dm.L);
            float* const Xp = B.X; const float* const MODc = B.MOD + (size_t)l * (NB + 1) * NMOD * D; const float* const MODn = lastl ? (const float*)nullptr : MODc + (size_t)(NB + 1) * NMOD * D;
#ifdef CPU_SHIM
            RUN_ITEMS(T, d_combine_ln2(gi_, B.H, Xp, B.Ob, B.tst, B.tokinfo, B.tokgate, MODc, MODn, in.ln2_g + l * D, in.ln2_b + l * D, ALPHA, B.Hb, out, dm));
#else
            const LAS int* tst = (const LAS int*)(lds + MISC_OFF + 64);
            const int tl = ltid();
            LAS float* vec = (LAS float*)(lds + RING_OFF);
            __syncthreads();
            { constexpr int NV = (2 * D + 3 * 3 * D) / 4;
              f32x4 vv[6];
#pragma unroll
              for (int it = 0; it < 6; ++it) { const int vi = tl + 512 * it < NV ? tl + 512 * it : 0; const float* sp;
                  if (vi < D / 4) sp = in.ln2_g + l * D + 4 * vi; else if (vi < D / 2) sp = in.ln2_b + l * D + 4 * (vi - D / 4);
                  else { const int w_ = vi - D / 2, r_ = w_ / (3 * D / 4), k4 = w_ % (3 * D / 4);
                      sp = k4 < D / 4 ? MODc + (size_t)r_ * NMOD * D + 5 * D + 4 * k4 : (MODn ? MODn : MODc) + (size_t)r_ * NMOD * D + 4 * (k4 - D / 4); }
                  vv[it] = *(const f32x4*)sp; }
              __builtin_amdgcn_sched_barrier(0);
#pragma unroll
              for (int it = 0; it < 6; ++it) if (tl + 512 * it < NV) *(LAS f32x4*)(vec + 4 * (tl + 512 * it)) = vv[it]; }
            __syncthreads();
            { auto qd_of = [&](int i) { return i < 2 ? (int)(blockIdx.x * 8 + (tl >> 6)) + i * NWG * 8 : (i == 2 && (tl >> 6) == 0 && (int)blockIdx.x < NWG / 2 ? 2 * NWG * 8 + (int)blockIdx.x : Dims::T / 4); };
              const int t0_ = 4 * qd_of(0) + ((tl & 63) >> 4);
              int4 ti_ = *(const int4*)(B.tokinfo + (size_t)t0_ * 4); float2 tg_ = *(const float2*)(B.tokgate + (size_t)t0_ * 2);
              for (int i = 0; i < 3; ++i) { const int qd = qd_of(i); if (qd >= Dims::T / 4) break;
                const int qn = qd_of(i + 1), tn = 4 * (qn < Dims::T / 4 ? qn : qd) + ((tl & 63) >> 4);
                const int4 tin = *(const int4*)(B.tokinfo + (size_t)tn * 4); const float2 tgn = *(const float2*)(B.tokgate + (size_t)tn * 2);
                combine_ln2_quad(4 * qd + ((tl & 63) >> 4), tl & 63, B.H, Xp, B.Ob, tst, ti_, tg_, vec, MODn != nullptr, ALPHA, B.Hb, out);
                ti_ = tin; tg_ = tgn; } }
#endif
        }
        GRID_SYNC();
        DUP_END
        DBG_DUMP("X2", l, B.X, T * D);
    }
#if defined(PROBE_K1) && !defined(CPU_SHIM)
    GRID_SYNC();
    {
        PHASE_ARGS(); const unsigned long long* ts_ = (const unsigned long long*)(A_->ws + 32768);
        const double total = (double)(ts_[1 + 2 + 11 * Dims::L] - ts_[1]); double c1 = 0.0, c2 = 0.0;
        for (int k = 0; k < 2 + 11 * Dims::L; ++k) { const int cat = k < 2 ? 0 : 1 + (k - 2) % 11; const double d = (double)(ts_[2 + k] - ts_[1 + k]); if (cat == PROBE_K1) c1 += d; if (cat == PROBE_K2) c2 += d; }
        const size_t nz = (size_t)((c1 / total) * (double)(NB * Dims::S)) * D;
        RUN_ITEMS(nz, out[gi_] = 0.0f);
        if (blockIdx.x == 0 && threadIdx.x == 0) out[(size_t)NB * Dims::S * D - 1] = (float)(1000.0 * c2 / total);
    }
#endif
}

#ifndef CPU_SHIM
__global__ void __launch_bounds__(512, 2) mega_fwd(Args a) {
    extern __shared__ __attribute__((aligned(16))) unsigned char lds_raw[];
    LAS unsigned char* lds = (LAS unsigned char*)lds_raw;
    if (threadIdx.x < 4) ((LAS unsigned*)(lds + MISC_OFF))[threadIdx.x] = 0u;
    __syncthreads();
    const XcdBarrier bar = xcd_barrier_post((unsigned*)(a.ws + WS_CTL), (volatile LAS unsigned*)(lds + MISC_OFF));
    PROBE_STAMP();
    forward_program(a.dm, bar, lds);
}
#endif
}

extern "C" void kernel_launch(void* const* d_in, const int* in_sizes, int n_in, void* d_out, int out_size, void* d_ws, size_t ws_size, hipStream_t stream) {
    nv::Args a{};
    const float** f = (const float**)&a.in;
    for (int i = 0; i < 36; ++i) f[i] = (const float*)d_in[i];
    a.out = (float*)d_out; a.ws = (char*)d_ws;
#ifdef CPU_SHIM
    a.dm.S = in_sizes[0] / (nv::NB * nv::D);
    a.dm.L = in_sizes[5] / (nv::NMOD * nv::D);
    a.dm.TPB = nv::CTX + a.dm.S; a.dm.T = nv::NB * a.dm.TPB;
    a.dm.nslots = ((a.dm.T * 2 + 127) / 128 + nv::NEXP) * 128; a.dm.pad = 0;
#else
    if (in_sizes[0] != nv::NB * nv::Dims::S * nv::D || in_sizes[5] != nv::Dims::L * nv::NMOD * nv::D) return;
#endif
    a.B = nv::make_bufs(a.ws, a.dm);
    if (a.B.ws_end > ws_size) return;
#ifdef CPU_SHIM
    nv::forward_program(a.in, a.B, a.out, a.dm);
#else
    static int grid = 0;
    if (grid == 0) {
        int dev = 0, cus = 0; if (hipGetDevice(&dev) != hipSuccess || hipDeviceGetAttribute(&cus, hipDeviceAttributeMultiprocessorCount, dev) != hipSuccess || cus <= 0) cus = 256;
        (void)hipFuncSetAttribute((const void*)nv::mega_fwd, hipFuncAttributeMaxDynamicSharedMemorySize, nv::LDS_BYTES);
        (void)hipGetLastError();
        grid = nv::NWG; (void)cus;
    }
    (void)hipMemsetAsync((char*)d_ws + nv::WS_CTL, 0, nv::CTL_BYTES, stream);
    hipLaunchKernelGGL(nv::mega_fwd, dim3(grid), dim3(512), nv::LDS_BYTES, stream, a);
#endif
}
```
